# Optimizing an MI355X kernel written in HIP

```python
import math
import jax, jax.numpy as jnp
from jax import lax
import numpy as np

D_MODEL = 1024
BATCH = 8
SEQ = 4096
DEPTH = 1

DSWA_CONFIGS = ((128, 1), (512, 4), (2048, 16))
N_GROUPS = len(DSWA_CONFIGS)
DSWA_HEADS = 4
DSWA_HEAD_DIM = 128
DSWA_WIDTH = N_GROUPS * DSWA_HEADS * DSWA_HEAD_DIM
DSWA_OUT = DSWA_HEADS * DSWA_HEAD_DIM
DSWA_BLK = 128
D_RNN = 1024
LRU_BLOCKS = 16
LRU_BW = D_RNN // LRU_BLOCKS
CONV_W = 4
LRU_C = 8.0
MEM_LEN = 256
MEM_HEADS = 4
MEM_HEAD_DIM = 128
MEM_WIDTH = MEM_HEADS * MEM_HEAD_DIM
N_BRANCHES = 3
IN_SPLITS = (DSWA_WIDTH, DSWA_WIDTH, DSWA_WIDTH, D_RNN, D_RNN, MEM_WIDTH, N_BRANCHES * D_MODEL)
D_IN = sum(IN_SPLITS)
PEER_HEADS = 8
PEER_KEY_DIM = 256
PEER_HALF = PEER_KEY_DIM // 2
N_KEYS = 128
N_EXPERTS = N_KEYS * N_KEYS
PEER_TOPK = 16
PEER_CHUNK = 128
ALPHA = (2.0 * DEPTH) ** 0.25
BETA = (8.0 * DEPTH) ** -0.25
LN_EPS = 1e-5
NEG_INF = -1e30

kernel_name = "hybrid_dswa_rglru_mem_peer_deepnorm"


def _layernorm(h, g, b):
    h = h.astype(jnp.float32)
    mu = jnp.mean(h, axis=-1, keepdims=True)
    var = jnp.mean(jnp.square(h - mu), axis=-1, keepdims=True)
    return (h - mu) * lax.rsqrt(var + LN_EPS) * g.astype(jnp.float32) + b.astype(jnp.float32)


def _dilated_window_attention(q, k, v, window, dilation):
    B, S, H, hd = q.shape
    steps = window // dilation
    assert steps <= DSWA_BLK
    span = dilation * DSWA_BLK
    sp = -(-S // span) * span
    m_len = sp // dilation
    nb = m_len // DSWA_BLK

    def to_sub(t):
        t = jnp.pad(t.astype(jnp.float32), ((0, 0), (0, sp - S), (0, 0), (0, 0)))
        t = t.reshape(B, m_len, dilation, H, hd).transpose(0, 2, 1, 3, 4)
        return t.reshape(B, dilation, nb, DSWA_BLK, H, hd)

    def with_prev(t):
        prev = jnp.pad(t[:, :, :-1], ((0, 0), (0, 0), (1, 0), (0, 0), (0, 0), (0, 0)))
        return jnp.concatenate([prev, t], axis=3)

    qb = to_sub(q)
    kw = with_prev(to_sub(k))
    vw = with_prev(to_sub(v))
    s = jnp.einsum('brnqhd,brnkhd->brnhqk', qb, kw) * (1.0 / math.sqrt(hd))
    qi = jnp.arange(DSWA_BLK)[:, None]
    kj = jnp.arange(2 * DSWA_BLK)[None, :]
    dist = DSWA_BLK + qi - kj
    band = (dist >= 0) & (dist <= steps)
    has_prev = (jnp.arange(nb) > 0)[:, None, None] | (kj >= DSWA_BLK)[None]
    valid = band[None] & has_prev
    s = jnp.where(valid[None, None, :, None], s, NEG_INF)
    lse = jax.nn.logsumexp(s, axis=-1)
    p = jnp.exp(s - lse[..., None])
    o = jnp.einsum('brnhqk,brnkhd->brnqhd', p, vw)
    o = o.reshape(B, dilation, m_len, H, hd).transpose(0, 2, 1, 3, 4).reshape(B, sp, H, hd)[:, :S]
    lse = lse.transpose(0, 1, 2, 4, 3).reshape(B, dilation, m_len, H)
    lse = lse.transpose(0, 2, 1, 3).reshape(B, sp, H)[:, :S]
    return o, lse


def _linear_recurrence(a, b):
    def comb(left, right):
        al, bl = left
        ar, br = right
        return al * ar, ar * bl + br
    _, h = lax.associative_scan(comb, (a, b), axis=1)
    return h


def _rglru_branch(xr, yg, conv_w, conv_b, wa, ba, wx, bx, lam):
    B, S, _ = xr.shape
    xc = lax.conv_general_dilated(
        xr.astype(jnp.float32), conv_w.astype(jnp.float32)[:, None, :],
        window_strides=(1,), padding=[(CONV_W - 1, 0)],
        dimension_numbers=('NWC', 'WIO', 'NWC'), feature_group_count=D_RNN,
    ) + conv_b.astype(jnp.float32)
    xh = xc.reshape(B, S, LRU_BLOCKS, LRU_BW)
    r = jax.nn.sigmoid(jnp.einsum('bsni,nij->bsnj', xh, wa.astype(jnp.float32)).reshape(B, S, D_RNN) + ba)
    i = jax.nn.sigmoid(jnp.einsum('bsni,nij->bsnj', xh, wx.astype(jnp.float32)).reshape(B, S, D_RNN) + bx)
    log_a = -LRU_C * r * jax.nn.softplus(-lam.astype(jnp.float32))
    a = jnp.exp(log_a)
    mult = jnp.sqrt(-jnp.expm1(2.0 * log_a))
    h = _linear_recurrence(a, mult * i * xc)
    return h * jax.nn.gelu(yg.astype(jnp.float32))


def _memory_attention(mq, mem, w_mem_kv):
    B, S, _ = mq.shape
    q = mq.astype(jnp.float32).reshape(B, S, MEM_HEADS, MEM_HEAD_DIM)
    kv = jnp.einsum('bmd,de->bme', mem.astype(jnp.float32), w_mem_kv.astype(jnp.float32))
    k, v = jnp.split(kv.reshape(B, MEM_LEN, 2, MEM_HEADS, MEM_HEAD_DIM), 2, axis=2)
    k, v = k[:, :, 0], v[:, :, 0]
    s = jnp.einsum('bshd,bmhd->bhsm', q, k) * (1.0 / math.sqrt(MEM_HEAD_DIM))
    p = jax.nn.softmax(s, axis=-1)
    return jnp.einsum('bhsm,bmhd->bshd', p, v).reshape(B, S, MEM_WIDTH)


def _peer(x, wq, keys, u, v):
    B, S, D = x.shape
    q = jnp.einsum('bsd,de->bse', x, wq.astype(jnp.float32)).reshape(B, S, PEER_HEADS, 2, PEER_HALF)
    sc = jnp.einsum('bshpc,hpnc->bshpn', q, keys.astype(jnp.float32))
    s_top, i_top = lax.top_k(sc, PEER_TOPK)
    cand = s_top[..., 0, :, None] + s_top[..., 1, None, :]
    c_s, c_i = lax.top_k(cand.reshape(B, S, PEER_HEADS, PEER_TOPK * PEER_TOPK), PEER_TOPK)
    ia = jnp.take_along_axis(i_top[..., 0, :], c_i // PEER_TOPK, axis=-1)
    ib = jnp.take_along_axis(i_top[..., 1, :], c_i % PEER_TOPK, axis=-1)
    ids = ia * N_KEYS + ib
    g = jax.nn.softmax(c_s, axis=-1)
    n_chunks = (B * S) // PEER_CHUNK
    xs = x.reshape(n_chunks, PEER_CHUNK, D)
    ids = ids.reshape(n_chunks, PEER_CHUNK, PEER_HEADS, PEER_TOPK)
    g = g.reshape(n_chunks, PEER_CHUNK, PEER_HEADS, PEER_TOPK)

    def block(args):
        xc, idc, gc = args
        act = jax.nn.gelu(jnp.einsum('thkd,td->thk', u[idc].astype(jnp.float32), xc), approximate=False)
        return jnp.einsum('thk,thkd->td', gc * act, v[idc].astype(jnp.float32))

    return lax.map(block, (xs, ids, g)).reshape(B, S, D)


def _hybrid_layer(x, mem, w_in, b_gate, conv_w, conv_b, lru_wa, lru_ba, lru_wx, lru_bx, lru_lambda,
                  w_mem_kv, w_br_attn, w_br_lru, w_br_mem, w_out, ln1_g, ln1_b,
                  peer_wq, peer_keys, peer_u, peer_v, ln2_g, ln2_b):
    B, S, D = x.shape
    z = jnp.einsum('bsd,de->bse', x, w_in.astype(jnp.float32))
    offs = [0]
    for w in IN_SPLITS:
        offs.append(offs[-1] + w)
    q, k, v, xr, yg, mq, gl = [z[..., offs[j]:offs[j + 1]] for j in range(len(IN_SPLITS))]

    hs = (B, S, N_GROUPS, DSWA_HEADS, DSWA_HEAD_DIM)
    q, k, v = q.reshape(hs), k.reshape(hs), v.reshape(hs)
    outs, lses = [], []
    for gi, (win, dil) in enumerate(DSWA_CONFIGS):
        o_g, l_g = _dilated_window_attention(q[:, :, gi], k[:, :, gi], v[:, :, gi], win, dil)
        outs.append(o_g)
        lses.append(l_g)
    wgt = jax.nn.softmax(jnp.stack(lses, axis=0), axis=0)
    attn = jnp.sum(wgt[..., None] * jnp.stack(outs, axis=0), axis=0).reshape(B, S, DSWA_OUT)

    rec = _rglru_branch(xr, yg, conv_w, conv_b, lru_wa, lru_ba, lru_wx, lru_bx, lru_lambda)

    memo = _memory_attention(mq, mem, w_mem_kv)

    gates = jax.nn.sigmoid(gl.reshape(B, S, N_BRANCHES, D) + b_gate.astype(jnp.float32))
    merged = (gates[:, :, 0] * (attn @ w_br_attn.astype(jnp.float32))
              + gates[:, :, 1] * (rec @ w_br_lru.astype(jnp.float32))
              + gates[:, :, 2] * (memo @ w_br_mem.astype(jnp.float32)))
    mix = merged @ w_out.astype(jnp.float32)
    x1 = _layernorm(ALPHA * x + mix, ln1_g, ln1_b)

    ffn = _peer(x1, peer_wq, peer_keys, peer_u, peer_v)
    return _layernorm(ALPHA * x1 + ffn, ln2_g, ln2_b)


def setup_inputs(seed: int = 0) -> dict:
    key = jax.random.key(seed)
    ks = jax.random.split(key, 26)
    f32 = jnp.float32
    L, D = DEPTH, D_MODEL

    def nrm(k, shape, scale):
        return jax.random.normal(k, shape, f32) * scale

    a0 = jax.random.uniform(ks[10], (L, D_RNN), f32, 0.9, 0.999)
    s0 = a0 ** (1.0 / LRU_C)
    lam = jnp.log(s0) - jnp.log1p(-s0)
    return {
        'x': nrm(ks[0], (BATCH, SEQ, D), 1.0),
        'mem': nrm(ks[1], (BATCH, MEM_LEN, D), 1.0),
        'w_in': nrm(ks[2], (L, D, D_IN), D ** -0.5),
        'b_gate': nrm(ks[3], (L, N_BRANCHES, D), 0.1),
        'conv_w': nrm(ks[4], (L, CONV_W, D_RNN), CONV_W ** -0.5),
        'conv_b': nrm(ks[5], (L, D_RNN), 0.01),
        'lru_wa': nrm(ks[6], (L, LRU_BLOCKS, LRU_BW, LRU_BW), LRU_BW ** -0.5),
        'lru_ba': nrm(ks[7], (L, D_RNN), 0.01),
        'lru_wx': nrm(ks[8], (L, LRU_BLOCKS, LRU_BW, LRU_BW), LRU_BW ** -0.5),
        'lru_bx': nrm(ks[9], (L, D_RNN), 0.01),
        'lru_lambda': lam,
        'w_mem_kv': nrm(ks[11], (L, D, 2 * MEM_WIDTH), D ** -0.5),
        'w_br_attn': nrm(ks[12], (L, DSWA_OUT, D), BETA * DSWA_OUT ** -0.5),
        'w_br_lru': nrm(ks[13], (L, D_RNN, D), BETA * D_RNN ** -0.5),
        'w_br_mem': nrm(ks[14], (L, MEM_WIDTH, D), BETA * MEM_WIDTH ** -0.5),
        'w_out': nrm(ks[15], (L, D, D), BETA * D ** -0.5),
        'ln1_g': 1.0 + nrm(ks[16], (L, D), 0.02),
        'ln1_b': nrm(ks[17], (L, D), 0.02),
        'peer_wq': nrm(ks[18], (L, D, PEER_HEADS * PEER_KEY_DIM), D ** -0.5),
        'peer_keys': nrm(ks[19], (L, PEER_HEADS, 2, N_KEYS, PEER_HALF), PEER_HALF ** -0.5),
        'peer_u': nrm(ks[20], (L, N_EXPERTS, D), D ** -0.5),
        'peer_v': nrm(ks[21], (L, N_EXPERTS, D), BETA * PEER_HEADS ** -0.5),
        'ln2_g': 1.0 + nrm(ks[22], (L, D), 0.02),
        'ln2_b': nrm(ks[23], (L, D), 0.02),
    }


def reference(x, mem, w_in, b_gate, conv_w, conv_b, lru_wa, lru_ba, lru_wx, lru_bx, lru_lambda,
              w_mem_kv, w_br_attn, w_br_lru, w_br_mem, w_out, ln1_g, ln1_b,
              peer_wq, peer_keys, peer_u, peer_v, ln2_g, ln2_b):
    h = x.astype(jnp.float32)
    for l in range(DEPTH):
        h = _hybrid_layer(h, mem, w_in[l], b_gate[l], conv_w[l], conv_b[l], lru_wa[l], lru_ba[l],
                          lru_wx[l], lru_bx[l], lru_lambda[l], w_mem_kv[l], w_br_attn[l], w_br_lru[l],
                          w_br_mem[l], w_out[l], ln1_g[l], ln1_b[l], peer_wq[l], peer_keys[l],
                          peer_u[l], peer_v[l], ln2_g[l], ln2_b[l])
    return h.astype(x.dtype)
```

```cpp
#include <hip/hip_runtime.h>
#include <hip/hip_cooperative_groups.h>
#include <stdint.h>
#include <stdio.h>
namespace cg = cooperative_groups;

typedef unsigned short u16;
typedef __attribute__((ext_vector_type(4))) unsigned u32x4;
typedef __attribute__((ext_vector_type(2))) unsigned u32x2;
typedef __attribute__((ext_vector_type(8))) short s16x8;
typedef __attribute__((ext_vector_type(16))) float f32x16;

constexpr int T_TOK = 32768;
constexpr int SEQ = 4096;
constexpr int DM = 1024;
constexpr int NGRP = 4;
constexpr int TG = T_TOK / NGRP;
constexpr int BPG = 2;
constexpr int D_IN = 10240;
constexpr float ALPHA = 1.189207115002721f;
constexpr float LN_EPS = 1e-5f;
constexpr float ATT_SCALE = 0.08838834764831845f;
constexpr float NEGBIG = -1e30f;

constexpr size_t OFF_WIN_T = 0;
constexpr size_t OFF_WBA_T = OFF_WIN_T + (size_t)10240 * 1024 * 2;
constexpr size_t OFF_WBL_T = OFF_WBA_T + (size_t)1024 * 512 * 2;
constexpr size_t OFF_WBM_T = OFF_WBL_T + (size_t)1024 * 1024 * 2;
constexpr size_t OFF_WOUT_T = OFF_WBM_T + (size_t)1024 * 512 * 2;
constexpr size_t OFF_WQ_T = OFF_WOUT_T + (size_t)1024 * 1024 * 2;
constexpr size_t OFF_KEYS = OFF_WQ_T + (size_t)2048 * 1024 * 2;
constexpr size_t OFF_WMKV_T = OFF_KEYS + (size_t)16 * 128 * 128 * 2;
constexpr size_t OFF_LWA_T = OFF_WMKV_T + (size_t)1024 * 1024 * 2;
constexpr size_t OFF_LWX_T = OFF_LWA_T + (size_t)16 * 64 * 64 * 2;
constexpr size_t OFF_MEMB = OFF_LWX_T + (size_t)16 * 64 * 64 * 2;
constexpr size_t OFF_MEMKV = OFF_MEMB + (size_t)2048 * 1024 * 2;
constexpr size_t OFF_UB = OFF_MEMKV + (size_t)2048 * 1024 * 2;
constexpr size_t OFF_VB = OFF_UB + (size_t)16384 * 1024 + 65536;
constexpr size_t OFF_CTR = OFF_VB + (size_t)16384 * 1024 + 65536;
constexpr size_t OFF_XB = OFF_CTR + 32768;
constexpr size_t OFF_MERGED = OFF_XB + (size_t)T_TOK * 1024 * 2;
constexpr size_t OFF_Z = OFF_MERGED + (size_t)T_TOK * 1024 * 2;
constexpr size_t OFF_ZQ = OFF_Z;
constexpr size_t OFF_ZK = OFF_ZQ + (size_t)TG * 1536 * 2;
constexpr size_t OFF_ZV = OFF_ZK + (size_t)TG * 1536 * 2;
constexpr size_t OFF_ZXR = OFF_ZV + (size_t)TG * 1536 * 2;
constexpr size_t OFF_ZYG = OFF_ZXR + (size_t)TG * 1024 * 2;
constexpr size_t OFF_ZMQ = OFF_ZYG + (size_t)TG * 1024 * 2;
constexpr size_t OFF_GATES = OFF_ZMQ + (size_t)TG * 512 * 2;
constexpr size_t OFF_GATES2 = OFF_GATES + (size_t)TG * 3072 * 2;
constexpr size_t OFF_OG = OFF_GATES2 + (size_t)TG * 3072 * 2;
constexpr size_t OFF_LSE = OFF_OG + (size_t)3 * TG * 512 * 2;
constexpr size_t OFF_MEMO = OFF_LSE + (size_t)3 * TG * 4 * 4;
constexpr size_t OFF_REC = OFF_MEMO + (size_t)TG * 512 * 2;
constexpr size_t OFF_ATTN = OFF_REC + (size_t)TG * 1024 * 2;
constexpr size_t OFF_HLOC = OFF_ATTN + (size_t)TG * 512 * 2;
constexpr size_t OFF_PCUM = OFF_HLOC + (size_t)TG * 1024 * 2;
constexpr size_t OFF_SUMA = OFF_PCUM + (size_t)TG * 1024 * 2;
constexpr size_t OFF_SUMH = OFF_SUMA + (size_t)BPG * 64 * 1024 * 4;
constexpr size_t OFF_ZEND = OFF_SUMH + (size_t)BPG * 64 * 1024 * 4;
constexpr size_t WS_END = OFF_ZEND;
constexpr size_t OFF_PQ = OFF_MERGED;
constexpr size_t OFF_Y = OFF_MERGED + (size_t)T_TOK * 2048 * 2;
constexpr size_t OFF_STOP = OFF_Y + (size_t)T_TOK * 1024 * 4;
constexpr size_t OFF_ITOP = OFF_STOP + (size_t)T_TOK * 256 * 4;
static_assert(OFF_ITOP + (size_t)T_TOK * 256 <= OFF_ZEND, "tail alias overflow");
static_assert(WS_END <= (size_t)512 * 1024 * 1024, "workspace too large");

constexpr int SMEM_BYTES = 73728;

struct Params {
  const float *x, *mem, *w_in, *b_gate, *conv_w, *conv_b, *lru_wa, *lru_ba, *lru_wx, *lru_bx, *lru_lambda,
      *w_mem_kv, *w_br_attn, *w_br_lru, *w_br_mem, *w_out, *ln1_g, *ln1_b, *peer_wq, *peer_keys, *peer_u, *peer_v,
      *ln2_g, *ln2_b;
  float* out;
  unsigned char* ws;
};

typedef __attribute__((ext_vector_type(2))) float f32x2_cv;
typedef __attribute__((ext_vector_type(2))) __bf16 bf16x2_cv;
__device__ __forceinline__ u16 f2bf(float f) { return __builtin_bit_cast(u16, (__bf16)f); }
__device__ __forceinline__ float bf2f(u16 h) { return __uint_as_float(((unsigned)h) << 16); }
__device__ __forceinline__ unsigned pack2(float a, float b) {
  f32x2_cv v = {a, b};
  return __builtin_bit_cast(unsigned, __builtin_convertvector(v, bf16x2_cv));
}
__device__ __forceinline__ float bflo(unsigned v) { return __uint_as_float(v << 16); }
__device__ __forceinline__ float bfhi(unsigned v) { return __uint_as_float(v & 0xffff0000u); }
__device__ __forceinline__ float sigmoidf_(float x) { return __builtin_amdgcn_rcpf(1.0f + __expf(-x)); }
__device__ __forceinline__ float gelu_tanh(float x) {
  float u = 0.7978845608028654f * (x + 0.044715f * x * x * x);
  return x * __builtin_amdgcn_rcpf(1.0f + __expf(-2.0f * u));
}
__device__ __forceinline__ float gelu_erf(float x) { return 0.5f * x * (1.0f + erff(x * 0.7071067811865476f)); }
template <int CTRL, int ROWMASK>
__device__ __forceinline__ float dpp_add0(float v) {
  return __builtin_bit_cast(float, __builtin_amdgcn_update_dpp(0, __builtin_bit_cast(int, v), CTRL, ROWMASK, 0xF, false));
}
template <int CTRL, int ROWMASK>
__device__ __forceinline__ float dpp_self(float v) {
  return __builtin_bit_cast(float, __builtin_amdgcn_update_dpp(__builtin_bit_cast(int, v), __builtin_bit_cast(int, v), CTRL, ROWMASK, 0xF, false));
}
__device__ __forceinline__ float wave_sum(float v) {
  v += dpp_add0<0xB1, 0xF>(v);
  v += dpp_add0<0x4E, 0xF>(v);
  v += dpp_add0<0x141, 0xF>(v);
  v += dpp_add0<0x140, 0xF>(v);
  v += dpp_add0<0x142, 0xA>(v);
  v += dpp_add0<0x143, 0xC>(v);
  return __builtin_bit_cast(float, __builtin_amdgcn_readlane(__builtin_bit_cast(int, v), 63));
}
__device__ __forceinline__ float half_sum(float v) {
  v += dpp_add0<0xB1, 0xF>(v);
  v += dpp_add0<0x4E, 0xF>(v);
  v += dpp_add0<0x141, 0xF>(v);
  v += dpp_add0<0x140, 0xF>(v);
  v += dpp_add0<0x142, 0xA>(v);
  const float lo = __builtin_bit_cast(float, __builtin_amdgcn_readlane(__builtin_bit_cast(int, v), 31));
  const float hi = __builtin_bit_cast(float, __builtin_amdgcn_readlane(__builtin_bit_cast(int, v), 63));
  return ((threadIdx.x & 32) != 0) ? hi : lo;
}
__device__ __forceinline__ float half_max(float v) {
  v = fmaxf(v, dpp_self<0xB1, 0xF>(v));
  v = fmaxf(v, dpp_self<0x4E, 0xF>(v));
  v = fmaxf(v, dpp_self<0x141, 0xF>(v));
  v = fmaxf(v, dpp_self<0x140, 0xF>(v));
  v = fmaxf(v, dpp_self<0x142, 0xA>(v));
  const float lo = __builtin_bit_cast(float, __builtin_amdgcn_readlane(__builtin_bit_cast(int, v), 31));
  const float hi = __builtin_bit_cast(float, __builtin_amdgcn_readlane(__builtin_bit_cast(int, v), 63));
  return ((threadIdx.x & 32) != 0) ? hi : lo;
}
__device__ __forceinline__ float wave_max_all(float v) {
  v = fmaxf(v, dpp_self<0xB1, 0xF>(v));
  v = fmaxf(v, dpp_self<0x4E, 0xF>(v));
  v = fmaxf(v, dpp_self<0x141, 0xF>(v));
  v = fmaxf(v, dpp_self<0x140, 0xF>(v));
  v = fmaxf(v, dpp_self<0x142, 0xA>(v));
  v = fmaxf(v, dpp_self<0x143, 0xC>(v));
  return __builtin_bit_cast(float, __builtin_amdgcn_readlane(__builtin_bit_cast(int, v), 63));
}
typedef __attribute__((ext_vector_type(2))) float f32x2;
__device__ __forceinline__ unsigned f2ord(float f) {
  unsigned b = __float_as_uint(f);
  return (b & 0x80000000u) ? ~b : (b | 0x80000000u);
}
__device__ __forceinline__ float ord2f(unsigned o) {
  return __uint_as_float((o & 0x80000000u) ? (o ^ 0x80000000u) : ~o);
}
#define TOPK_INSERT(L, x)                                   \
  {                                                         \
    unsigned x_ = (x);                                      \
    _Pragma("unroll") for (int j_ = 0; j_ < 16; ++j_) {     \
      unsigned t_ = max(L[j_], x_);                         \
      x_ = min(L[j_], x_);                                  \
      L[j_] = t_;                                           \
    }                                                       \
  }
__device__ __forceinline__ int otid() {
  int t;
  asm volatile("v_mov_b32 %0, %1" : "=v"(t) : "v"(threadIdx.x));
  return t;
}
__device__ __forceinline__ f32x16 mfma32(s16x8 a, s16x8 b, f32x16 c) {
  return __builtin_amdgcn_mfma_f32_32x32x16_bf16(a, b, c, 0, 0, 0);
}
__device__ __forceinline__ f32x16 zero16() {
  f32x16 z;
#pragma unroll
  for (int i = 0; i < 16; ++i) z[i] = 0.f;
  return z;
}

template <int DEPTH, class LA>
__device__ __forceinline__ void gemm_mainloop_t(f32x16 (&acc)[2][2], LA la, const u16* __restrict__ Bt, unsigned ldb,
                                                int K, u16* smem) {
  const int tid = otid(), lane = tid & 63, w = tid >> 6, wm = w & 1, wn = w >> 1;
  const unsigned boff = (unsigned)(tid >> 3) * ldb + (tid & 7) * 8;
  const unsigned soff = (unsigned)(tid >> 3) * 72 + (tid & 7) * 8;
  la.init(tid);
  u32x4 ra0[4], rb0[4], ra1[4], rb1[4];
#pragma unroll
  for (int i = 0; i < 4; ++i) {
    ra0[i] = la.load(i, 0);
    rb0[i] = *(const u32x4*)(Bt + (size_t)(32 * i) * ldb + boff);
  }
  if (DEPTH == 2) {
    const int k1 = (64 < K) ? 64 : 0;
#pragma unroll
    for (int i = 0; i < 4; ++i) {
      ra1[i] = la.load(i, k1);
      rb1[i] = *(const u32x4*)(Bt + (size_t)(32 * i) * ldb + k1 + boff);
    }
  }
  __syncthreads();
  int buf = 0;
  for (int k0 = 0; k0 < K; k0 += 64 * DEPTH) {
#pragma unroll
    for (int ph = 0; ph < DEPTH; ++ph) {
      u16* sA = smem + buf * (2 * 128 * 72);
      u16* sB = sA + 128 * 72;
#pragma unroll
      for (int i = 0; i < 4; ++i) {
        *(u32x4*)(sA + i * 32 * 72 + soff) = (ph == 0) ? ra0[i] : ra1[i];
        *(u32x4*)(sB + i * 32 * 72 + soff) = (ph == 0) ? rb0[i] : rb1[i];
      }
      __syncthreads();
      {
        int kn = k0 + 64 * ph + 64 * DEPTH;
        kn = (kn < K) ? kn : 0;
#pragma unroll
        for (int i = 0; i < 4; ++i) {
          if (ph == 0) {
            ra0[i] = la.load(i, kn);
            rb0[i] = *(const u32x4*)(Bt + (size_t)(32 * i) * ldb + kn + boff);
          } else {
            ra1[i] = la.load(i, kn);
            rb1[i] = *(const u32x4*)(Bt + (size_t)(32 * i) * ldb + kn + boff);
          }
        }
      }
      const u16* pa = sA + (wm * 64 + (lane & 31)) * 72 + (lane >> 5) * 8;
      const u16* pb = sB + (wn * 64 + (lane & 31)) * 72 + (lane >> 5) * 8;
#pragma unroll
      for (int ks = 0; ks < 4; ++ks) {
        s16x8 a0 = *(const s16x8*)(pa + ks * 16);
        s16x8 a1 = *(const s16x8*)(pa + 32 * 72 + ks * 16);
        s16x8 b0 = *(const s16x8*)(pb + ks * 16);
        s16x8 b1 = *(const s16x8*)(pb + 32 * 72 + ks * 16);
        acc[0][0] = mfma32(a0, b0, acc[0][0]);
        acc[0][1] = mfma32(a0, b1, acc[0][1]);
        acc[1][0] = mfma32(a1, b0, acc[1][0]);
        acc[1][1] = mfma32(a1, b1, acc[1][1]);
      }
      buf ^= 1;
    }
  }
}
template <class LA>
__device__ __forceinline__ void gemm_mainloop(f32x16 (&acc)[2][2], LA la, const u16* __restrict__ Bt, unsigned ldb, int K,
                                              u16* smem) {
  gemm_mainloop_t<2, LA>(acc, la, Bt, ldb, K, smem);
}

template <class LA>
__device__ __forceinline__ void gemm_mainloop_wide(f32x16 (&acc)[2][4], LA la, const u16* __restrict__ Bt, unsigned ldb,
                                                   int K, u16* smem) {
  u16* sA = smem;
  u16* sB = smem + 128 * 72;
  const int tid = otid(), lane = tid & 63, w = tid >> 6, wm = w & 1, wn = w >> 1;
  const unsigned boff = (unsigned)(tid >> 3) * ldb + (tid & 7) * 8;
  const unsigned soff = (unsigned)(tid >> 3) * 72 + (tid & 7) * 8;
  la.init(tid);
  u32x4 ra[4], rb[8];
#pragma unroll
  for (int i = 0; i < 4; ++i) ra[i] = la.load(i, 0);
#pragma unroll
  for (int i = 0; i < 8; ++i) rb[i] = *(const u32x4*)(Bt + (size_t)(32 * i) * ldb + boff);
  for (int k0 = 0; k0 < K; k0 += 64) {
    __syncthreads();
#pragma unroll
    for (int i = 0; i < 4; ++i) *(u32x4*)(sA + i * 32 * 72 + soff) = ra[i];
#pragma unroll
    for (int i = 0; i < 8; ++i) *(u32x4*)(sB + i * 32 * 72 + soff) = rb[i];
    __syncthreads();
    {
      const int kn = (k0 + 64 < K) ? (k0 + 64) : 0;
#pragma unroll
      for (int i = 0; i < 4; ++i) ra[i] = la.load(i, kn);
#pragma unroll
      for (int i = 0; i < 8; ++i) rb[i] = *(const u32x4*)(Bt + (size_t)(32 * i) * ldb + kn + boff);
    }
    const u16* pa = sA + (wm * 64 + (lane & 31)) * 72 + (lane >> 5) * 8;
    const u16* pb = sB + (wn * 32 + (lane & 31)) * 72 + (lane >> 5) * 8;
#pragma unroll
    for (int ks = 0; ks < 4; ++ks) {
      s16x8 a0 = *(const s16x8*)(pa + ks * 16);
      s16x8 a1 = *(const s16x8*)(pa + 32 * 72 + ks * 16);
#pragma unroll
      for (int ni = 0; ni < 4; ++ni) {
        s16x8 b = *(const s16x8*)(pb + ni * 64 * 72 + ks * 16);
        acc[0][ni] = mfma32(a0, b, acc[0][ni]);
        acc[1][ni] = mfma32(a1, b, acc[1][ni]);
      }
    }
  }
}
template <int H2>
__device__ __forceinline__ void acc_to_lds_wide(f32x16 (&acc)[2][4], float* sC) {
  const int lane = otid() & 63, w = otid() >> 6, wm = w & 1, wn = w >> 1;
  __syncthreads();
  float* p = sC + (wm * 64 + (lane >> 5) * 4) * 132 + wn * 32 + (lane & 31);
#pragma unroll
  for (int mi = 0; mi < 2; ++mi)
#pragma unroll
    for (int j = 0; j < 2; ++j)
#pragma unroll
      for (int i = 0; i < 16; ++i) p[(mi * 32 + (i >> 2) * 8 + (i & 3)) * 132 + j * 64] = acc[mi][2 * H2 + j][i];
  __syncthreads();
}

struct LoadBf16 {
  const u16* A;
  unsigned lda;
  unsigned off;
  __device__ __forceinline__ void init(int tid) { off = (unsigned)(tid >> 3) * lda + (tid & 7) * 8; }
  __device__ __forceinline__ u32x4 load(int i, int k0) const {
    return *(const u32x4*)(A + (size_t)(32 * i) * lda + k0 + off);
  }
};

__device__ __forceinline__ void acc_to_lds(f32x16 (&acc)[2][2], float* sC) {
  const int lane = otid() & 63, w = otid() >> 6, wm = w & 1, wn = w >> 1;
  __syncthreads();
  float* p = sC + (wm * 64 + (lane >> 5) * 4) * 132 + wn * 64 + (lane & 31);
#pragma unroll
  for (int mi = 0; mi < 2; ++mi)
#pragma unroll
    for (int ni = 0; ni < 2; ++ni)
#pragma unroll
      for (int i = 0; i < 16; ++i) p[(mi * 32 + (i >> 2) * 8 + (i & 3)) * 132 + ni * 32] = acc[mi][ni][i];
  __syncthreads();
}
typedef __attribute__((ext_vector_type(4))) float f32x4;
__device__ __forceinline__ u32x4 pack8(f32x4 a, f32x4 b) {
  u32x4 o;
  o.x = pack2(a.x, a.y); o.y = pack2(a.z, a.w); o.z = pack2(b.x, b.y); o.w = pack2(b.z, b.w);
  return o;
}
__device__ __forceinline__ void acc_zero(f32x16 (&acc)[2][2]) {
#pragma unroll
  for (int mi = 0; mi < 2; ++mi)
#pragma unroll
    for (int ni = 0; ni < 2; ++ni) acc[mi][ni] = zero16();
}

__device__ void convert_span(const float* __restrict__ src, u16* __restrict__ dst, size_t n) {
  size_t gt = (size_t)blockIdx.x * 256 + otid(), gs = (size_t)gridDim.x * 256;
  for (size_t i = gt * 8; i < n; i += gs * 8) {
    float4 a = *(const float4*)(src + i), b = *(const float4*)(src + i + 4);
    u32x4 o;
    o.x = pack2(a.x, a.y); o.y = pack2(a.z, a.w); o.z = pack2(b.x, b.y); o.w = pack2(b.z, b.w);
    *(u32x4*)(dst + i) = o;
  }
}
__device__ void transpose_tile(const float* __restrict__ src, int R, int C, u16* __restrict__ dst, int tr, int tc,
                               float* sm) {
  const int tid = otid();
  __syncthreads();
#pragma unroll
  for (int i = 0; i < 4; ++i) {
    int r = (tid >> 4) + 16 * i, c4 = (tid & 15) * 4;
    float4 v = *(const float4*)(src + (size_t)(tr * 64 + r) * C + tc * 64 + c4);
    sm[r * 65 + c4 + 0] = v.x; sm[r * 65 + c4 + 1] = v.y; sm[r * 65 + c4 + 2] = v.z; sm[r * 65 + c4 + 3] = v.w;
  }
  __syncthreads();
#pragma unroll
  for (int i = 0; i < 2; ++i) {
    int c = (tid >> 3) + 32 * i, r8 = (tid & 7) * 8;
    float e[8];
#pragma unroll
    for (int j = 0; j < 8; ++j) e[j] = sm[(r8 + j) * 65 + c];
    u32x4 o;
    o.x = pack2(e[0], e[1]); o.y = pack2(e[2], e[3]); o.z = pack2(e[4], e[5]); o.w = pack2(e[6], e[7]);
    *(u32x4*)(dst + (size_t)(tc * 64 + c) * R + tr * 64 + r8) = o;
  }
}

__device__ void quantize_rows_fp8(const float* __restrict__ src, unsigned char* __restrict__ dst, float* __restrict__ inv_scale) {
  const int lane = otid() & 63;
  const int gw = blockIdx.x * 4 + (otid() >> 6), nw = gridDim.x * 4;
  for (int row = gw; row < 16384; row += nw) {
    const float* p = src + (size_t)row * 1024 + lane * 16;
    f32x4 v[4];
    float am = 0.f;
#pragma unroll
    for (int q = 0; q < 4; ++q) {
      v[q] = *(const f32x4*)(p + 4 * q);
      am = fmaxf(am, fmaxf(fmaxf(fabsf(v[q].x), fabsf(v[q].y)), fmaxf(fabsf(v[q].z), fabsf(v[q].w))));
    }
    am = wave_max_all(am);
    const float sc = (am > 0.f) ? 224.0f / am : 1.0f;
    u32x4 o;
#pragma unroll
    for (int q = 0; q < 4; ++q) {
      int wv = __builtin_amdgcn_cvt_pk_fp8_f32(v[q].x * sc, v[q].y * sc, 0, false);
      wv = __builtin_amdgcn_cvt_pk_fp8_f32(v[q].z * sc, v[q].w * sc, wv, true);
      o[q] = (unsigned)wv;
    }
    *(u32x4*)(dst + (size_t)row * 1024 + lane * 16) = o;
    if (lane == 0) inv_scale[row] = (am > 0.f) ? am * (1.0f / 224.0f) : 1.0f;
  }
}

__device__ void quantize_rows_fp4(const float* __restrict__ src, unsigned char* __restrict__ dst, float* __restrict__ inv_scale) {
  const int lane = otid() & 63;
  const int gw = blockIdx.x * 4 + (otid() >> 6), nw = gridDim.x * 4;
  for (int row = gw; row < 16384; row += nw) {
    const float* p = src + (size_t)row * 1024 + lane * 16;
    f32x4 v[4];
    float am = 0.f;
#pragma unroll
    for (int q = 0; q < 4; ++q) {
      v[q] = *(const f32x4*)(p + 4 * q);
      am = fmaxf(am, fmaxf(fmaxf(fabsf(v[q].x), fabsf(v[q].y)), fmaxf(fabsf(v[q].z), fabsf(v[q].w))));
    }
    am = wave_max_all(am);
    const float sc = (am > 0.f) ? 6.0f / am : 1.0f;
    u32x2 o;
#pragma unroll
    for (int wd = 0; wd < 2; ++wd) {
      unsigned wv = 0u;
      wv = __builtin_amdgcn_cvt_scalef32_pk_fp4_f32(wv, v[2 * wd].x * sc, v[2 * wd].y * sc, 1.0f, 0);
      wv = __builtin_amdgcn_cvt_scalef32_pk_fp4_f32(wv, v[2 * wd].z * sc, v[2 * wd].w * sc, 1.0f, 1);
      wv = __builtin_amdgcn_cvt_scalef32_pk_fp4_f32(wv, v[2 * wd + 1].x * sc, v[2 * wd + 1].y * sc, 1.0f, 2);
      wv = __builtin_amdgcn_cvt_scalef32_pk_fp4_f32(wv, v[2 * wd + 1].z * sc, v[2 * wd + 1].w * sc, 1.0f, 3);
      o[wd] = wv;
    }
    *(u32x2*)(dst + (size_t)row * 512 + lane * 8) = o;
    if (lane == 0) inv_scale[row] = (am > 0.f) ? am * (1.0f / 6.0f) : 1.0f;
  }
}

__device__ void phase_prep(const Params& P, unsigned char* smem, int part) {
  unsigned char* ws = P.ws;
  if (part == 0) {
    convert_span(P.x, (u16*)(ws + OFF_XB), (size_t)TG * 1024);
    convert_span(P.mem, (u16*)(ws + OFF_MEMB), (size_t)2048 * 1024);
  } else {
    convert_span(P.x + (size_t)TG * 1024, (u16*)(ws + OFF_XB) + (size_t)TG * 1024, (size_t)(T_TOK - TG) * 1024);
    convert_span(P.peer_keys, (u16*)(ws + OFF_KEYS), (size_t)16 * 128 * 128);
  }
  constexpr int N0 = 16 * 160, N1 = 8 * 16, N2 = 16 * 16, N3 = 8 * 16, N4 = 16 * 16, N5 = 16 * 32, N6 = 16 * 16, N7 = 16, N8 = 16;
  constexpr int NT = N0 + N1 + N2 + N3 + N4 + N5 + N6 + N7 + N8;
  float* sm = (float*)smem;
  for (int t = blockIdx.x; t < NT; t += gridDim.x) {
    int u = t;
    const bool early = (t < N0) || (t >= N0 + N1 + N2 + N3 + N4 + N5);
    if (early != (part == 0)) continue;
    if (u < N0) { transpose_tile(P.w_in, 1024, D_IN, (u16*)(ws + OFF_WIN_T), u / 160, u % 160, sm); continue; }
    u -= N0;
    if (u < N1) { transpose_tile(P.w_br_attn, 512, 1024, (u16*)(ws + OFF_WBA_T), u / 16, u % 16, sm); continue; }
    u -= N1;
    if (u < N2) { transpose_tile(P.w_br_lru, 1024, 1024, (u16*)(ws + OFF_WBL_T), u / 16, u % 16, sm); continue; }
    u -= N2;
    if (u < N3) { transpose_tile(P.w_br_mem, 512, 1024, (u16*)(ws + OFF_WBM_T), u / 16, u % 16, sm); continue; }
    u -= N3;
    if (u < N4) { transpose_tile(P.w_out, 1024, 1024, (u16*)(ws + OFF_WOUT_T), u / 16, u % 16, sm); continue; }
    u -= N4;
    if (u < N5) { transpose_tile(P.peer_wq, 1024, 2048, (u16*)(ws + OFF_WQ_T), u / 32, u % 32, sm); continue; }
    u -= N5;
    if (u < N6) { transpose_tile(P.w_mem_kv, 1024, 1024, (u16*)(ws + OFF_WMKV_T), u / 16, u % 16, sm); continue; }
    u -= N6;
    if (u < N7) { transpose_tile(P.lru_wa + (size_t)u * 4096, 64, 64, (u16*)(ws + OFF_LWA_T) + (size_t)u * 4096, 0, 0, sm); continue; }
    u -= N7;
    transpose_tile(P.lru_wx + (size_t)u * 4096, 64, 64, (u16*)(ws + OFF_LWX_T) + (size_t)u * 4096, 0, 0, sm);
  }
}

template <int H2>
__device__ __forceinline__ void inproj_store_half(const Params& P, f32x16 (&acc)[2][4], unsigned char* smem, u16* dst, int ld,
                                                  int c0, int rt, bool is_gate) {
  acc_to_lds_wide<H2>(acc, (float*)smem);
  const float* sC = (const float*)smem;
  const int cb = c0 + H2 * 128;
  if (!is_gate) {
#pragma unroll 2
    for (int it = 0; it < 8; ++it) {
      const int idx = otid() + 256 * it, row = idx >> 4, c8 = (idx & 15) * 8;
      f32x4 v0 = *(const f32x4*)(sC + row * 132 + c8), v1 = *(const f32x4*)(sC + row * 132 + c8 + 4);
      __builtin_nontemporal_store(pack8(v0, v1), (u32x4*)(dst + (size_t)(rt * 128 + row) * ld + cb + c8));
    }
  } else {
    const float* bg = P.b_gate + cb;
#pragma unroll 2
    for (int it = 0; it < 8; ++it) {
      const int idx = otid() + 256 * it, row = idx >> 4, c8 = (idx & 15) * 8;
      f32x4 v0 = *(const f32x4*)(sC + row * 132 + c8), v1 = *(const f32x4*)(sC + row * 132 + c8 + 4);
      f32x4 b0 = *(const f32x4*)(bg + c8), b1 = *(const f32x4*)(bg + c8 + 4);
#pragma unroll
      for (int j = 0; j < 4; ++j) { v0[j] = sigmoidf_(v0[j] + b0[j]); v1[j] = sigmoidf_(v1[j] + b1[j]); }
      __builtin_nontemporal_store(pack8(v0, v1), (u32x4*)(dst + (size_t)(rt * 128 + row) * ld + cb + c8));
    }
  }
}

__device__ void phase_inproj(const Params& P, int g, unsigned char* smem) {
  unsigned char* ws = P.ws;
  const u16* xb = (const u16*)(ws + OFF_XB) + (size_t)g * TG * 1024;
  const u16* wt = (const u16*)(ws + OFF_WIN_T);
  constexpr int NRT = TG / 128;
  constexpr int NCT = D_IN / 256;
  for (int t = blockIdx.x; t < NRT * NCT; t += gridDim.x) {
    const int ct = t / NRT, rt = t % NRT;
    f32x16 acc[2][4];
#pragma unroll
    for (int mi = 0; mi < 2; ++mi)
#pragma unroll
      for (int ni = 0; ni < 4; ++ni) acc[mi][ni] = zero16();
    LoadBf16 la{xb + (size_t)rt * 128 * 1024, 1024, 0};
    gemm_mainloop_wide(acc, la, wt + (size_t)ct * 256 * 1024, 1024, 1024, (u16*)smem);
    const int n0 = ct * 256;
    u16* dst; int ld, c0;
    if (n0 < 1536) { dst = (u16*)(ws + OFF_ZQ); ld = 1536; c0 = n0; }
    else if (n0 < 3072) { dst = (u16*)(ws + OFF_ZK); ld = 1536; c0 = n0 - 1536; }
    else if (n0 < 4608) { dst = (u16*)(ws + OFF_ZV); ld = 1536; c0 = n0 - 3072; }
    else if (n0 < 5632) { dst = (u16*)(ws + OFF_ZXR); ld = 1024; c0 = n0 - 4608; }
    else if (n0 < 6656) { dst = (u16*)(ws + OFF_ZYG); ld = 1024; c0 = n0 - 5632; }
    else if (n0 < 7168) { dst = (u16*)(ws + OFF_ZMQ); ld = 512; c0 = n0 - 6656; }
    else { dst = (u16*)(ws + ((g & 1) ? OFF_GATES2 : OFF_GATES)); ld = 3072; c0 = n0 - 7168; }
    const bool is_gate = (n0 >= 7168);
    inproj_store_half<0>(P, acc, smem, dst, ld, c0, rt, is_gate);
    inproj_store_half<1>(P, acc, smem, dst, ld, c0, rt, is_gate);
  }
  if (g == 0) {
    for (int u = blockIdx.x; u < 16 * 8; u += gridDim.x) {
      const int ct = u / 16, rt = u % 16;
      f32x16 acc[2][2];
      acc_zero(acc);
      LoadBf16 la{(const u16*)(ws + OFF_MEMB) + (size_t)rt * 128 * 1024, 1024, 0};
      gemm_mainloop(acc, la, (const u16*)(ws + OFF_WMKV_T) + (size_t)ct * 128 * 1024, 1024, 1024, (u16*)smem);
      u16* dst = (u16*)(ws + OFF_MEMKV);
      acc_to_lds(acc, (float*)smem);
      const float* sC = (const float*)smem;
#pragma unroll 2
      for (int it = 0; it < 8; ++it) {
        const int idx = otid() + 256 * it, row = idx >> 4, c8 = (idx & 15) * 8;
        f32x4 v0 = *(const f32x4*)(sC + row * 132 + c8), v1 = *(const f32x4*)(sC + row * 132 + c8 + 4);
        *(u32x4*)(dst + (size_t)(rt * 128 + row) * 1024 + ct * 128 + c8) = pack8(v0, v1);
      }
    }
  }
}

__device__ __forceinline__ void attn_block(const u16* __restrict__ Q, size_t qs, const u16* __restrict__ K0,
                                           const u16* __restrict__ V0, int mode0, const u16* __restrict__ K1,
                                           const u16* __restrict__ V1, int mode1, size_t kvs, u16* __restrict__ O, size_t os,
                                           float* __restrict__ lse, size_t lses, u16* smem) {
  typedef __attribute__((ext_vector_type(4))) short s16x4;
  typedef __attribute__((address_space(3))) s16x4 lds_s16x4;
  u16* sK = smem;
  u16* sV = smem + 64 * 136;
  const int tid = otid(), lane = tid & 63, w = tid >> 6, hh = lane >> 5;
  size_t qoff = (size_t)(w * 32 + (lane & 31)) * qs + hh * 8;
  f32x16 o[4];
#pragma unroll
  for (int dt = 0; dt < 4; ++dt) o[dt] = zero16();
  float m_run = NEGBIG, l_run = 0.f;
  const int trq = (lane & 15) >> 2, trp = lane & 3, trg = lane >> 4;
  const u16* trbase = sV + ((trg >> 1) * 4 + trq) * 160 + (trg & 1) * 16 + trp * 4;
  constexpr float C2 = ATT_SCALE * 1.4426950408889634f;
  const int qrow = w * 32 + (lane & 31);

  u32x4 pk[4], pv[4];
#pragma unroll
  for (int i = 0; i < 4; ++i) {
    int id = tid + 256 * i, row = id >> 4, c = id & 15;
    pk[i] = *(const u32x4*)(K0 + (size_t)row * kvs + c * 8);
    pv[i] = *(const u32x4*)(V0 + (size_t)row * kvs + c * 8);
  }
  s16x8 qf[8];
#pragma unroll
  for (int ks = 0; ks < 8; ++ks) qf[ks] = *(const s16x8*)(Q + qoff + ks * 16);
#pragma unroll 1
  for (int sb = 0; sb < 4; ++sb) {
    const int hf = sb >> 1;
    const int mode = hf ? mode1 : mode0;
    if (mode < 0) continue;
    const int kbase = (sb & 1) * 64;
    const bool active = (mode == 0) || (mode == 1 ? (kbase <= w * 32 + 31) : (kbase + 63 >= w * 32));
    const bool need_mask = (mode != 0) && (mode == 1 ? (kbase + 63 > w * 32) : (kbase < w * 32 + 31));
    __syncthreads();
#pragma unroll
    for (int i = 0; i < 4; ++i) {
      int id = tid + 256 * i, row = id >> 4, c = id & 15;
      *(u32x4*)(sK + row * 136 + c * 8) = pk[i];
      *(u32x4*)(sV + row * 160 + c * 8) = pv[i];
    }
    __syncthreads();
    {
      const int nsb = sb + 1;
      const int nmode = (nsb >> 1) ? mode1 : mode0;
      if (nsb < 4 && nmode >= 0) {
        const u16* Kn = ((nsb >> 1) ? K1 : K0) + (size_t)((nsb & 1) * 64) * kvs;
        const u16* Vn = ((nsb >> 1) ? V1 : V0) + (size_t)((nsb & 1) * 64) * kvs;
#pragma unroll
        for (int i = 0; i < 4; ++i) {
          int id = tid + 256 * i, row = id >> 4, c = id & 15;
          pk[i] = *(const u32x4*)(Kn + (size_t)row * kvs + c * 8);
          pv[i] = *(const u32x4*)(Vn + (size_t)row * kvs + c * 8);
        }
      }
    }
    if (active) {
      f32x16 s[2];
      s[0] = zero16(); s[1] = zero16();
#pragma unroll
      for (int ks = 0; ks < 8; ++ks) {
#pragma unroll
        for (int nt = 0; nt < 2; ++nt) {
          s16x8 kfr = *(const s16x8*)(sK + (nt * 32 + (lane & 31)) * 136 + ks * 16 + hh * 8);
          s[nt] = mfma32(kfr, qf[ks], s[nt]);
        }
      }
      float mx = NEGBIG;
      if (need_mask) {
#pragma unroll
        for (int nt = 0; nt < 2; ++nt)
#pragma unroll
          for (int i = 0; i < 16; ++i) {
            const int key = kbase + nt * 32 + (i >> 2) * 8 + hh * 4 + (i & 3);
            const bool ok = (mode == 1) ? (key <= qrow) : (key >= qrow);
            s[nt][i] = ok ? s[nt][i] : NEGBIG;
          }
      }
#pragma unroll
      for (int nt = 0; nt < 2; ++nt)
#pragma unroll
        for (int i = 0; i < 16; ++i) mx = fmaxf(mx, s[nt][i]);
      mx = fmaxf(mx, __shfl_xor(mx, 32, 64));
      const float m_new = fmaxf(m_run, mx);
      const float alpha = __builtin_amdgcn_exp2f((m_run - m_new) * C2);
      m_run = m_new;
      const float mc = -m_new * C2;
      float ps = 0.f;
#pragma unroll
      for (int nt = 0; nt < 2; ++nt)
#pragma unroll
        for (int i = 0; i < 16; ++i) {
          const float p = __builtin_amdgcn_exp2f(fmaf(s[nt][i], C2, mc));
          s[nt][i] = p;
          ps += p;
        }
      l_run = l_run * alpha + ps;
#pragma unroll
      for (int dt = 0; dt < 4; ++dt)
#pragma unroll
        for (int i = 0; i < 16; ++i) o[dt][i] *= alpha;
#pragma unroll
      for (int nt = 0; nt < 2; ++nt)
#pragma unroll
        for (int s2 = 0; s2 < 2; ++s2) {
          u32x4 pb;
          pb.x = pack2(s[nt][8 * s2 + 0], s[nt][8 * s2 + 1]);
          pb.y = pack2(s[nt][8 * s2 + 2], s[nt][8 * s2 + 3]);
          pb.z = pack2(s[nt][8 * s2 + 4], s[nt][8 * s2 + 5]);
          pb.w = pack2(s[nt][8 * s2 + 6], s[nt][8 * s2 + 7]);
          const s16x8 pfr = __builtin_bit_cast(s16x8, pb);
#pragma unroll
          for (int dt = 0; dt < 4; ++dt) {
            const u16* ptr = trbase + (nt * 32 + s2 * 16) * 160 + dt * 32;
            s16x4 r1 = __builtin_amdgcn_ds_read_tr16_b64_v4i16((lds_s16x4*)ptr);
            s16x4 r2 = __builtin_amdgcn_ds_read_tr16_b64_v4i16((lds_s16x4*)(ptr + 8 * 160));
            s16x8 vfr = {r1[0], r1[1], r1[2], r1[3], r2[0], r2[1], r2[2], r2[3]};
            o[dt] = mfma32(vfr, pfr, o[dt]);
          }
        }
    }
  }
  const float l_tot = l_run + __shfl_xor(l_run, 32, 64);
  const float inv = 1.0f / l_tot;
  __syncthreads();
  u16* sO = smem + w * 32 * 136;
#pragma unroll
  for (int dt = 0; dt < 4; ++dt)
#pragma unroll
    for (int g4 = 0; g4 < 4; ++g4) {
      u32x2 pr;
      pr.x = pack2(o[dt][4 * g4 + 0] * inv, o[dt][4 * g4 + 1] * inv);
      pr.y = pack2(o[dt][4 * g4 + 2] * inv, o[dt][4 * g4 + 3] * inv);
      *(u32x2*)(sO + (lane & 31) * 136 + dt * 32 + g4 * 8 + hh * 4) = pr;
    }
  if (lse != nullptr && lane < 32) lse[(size_t)(w * 32 + lane) * lses] = m_run * ATT_SCALE + __logf(l_tot);
  __syncthreads();
#pragma unroll 2
  for (int it = 0; it < 8; ++it) {
    const int ch = lane + 64 * it, r = ch >> 4, c = ch & 15;
    *(u32x4*)(O + (size_t)(w * 32 + r) * os + c * 8) = *(const u32x4*)(sO + r * 136 + c * 8);
  }
}

__device__ __forceinline__ void lru_chunk_item(const Params& P, int b_local, int nb, int grp4, unsigned char* smem) {
  unsigned char* ws = P.ws;
  const int tid = otid(), lane = tid & 63, w = tid >> 6, tm = w & 1, tn = w >> 1;
  const int c0 = nb * 64;
  float* sXr = (float*)smem;
  float* sAa = sXr;
  float* sXc = sXr + 67 * 65;
  float* sBb = sXc + 64 * 65;
  float* sSegA = sBb + 64 * 65;
  float* sSegH = sSegA + 256;
  u16* sA = (u16*)(sSegH + 256);
  float* sHg = (float*)(sA + 64 * 72);
  float* sPg = sHg + 64;
  const size_t tokb = (size_t)b_local * SEQ;
  const u16* zxr = (const u16*)(ws + OFF_ZXR) + tokb * 1024 + c0;
  u16* hloc = (u16*)(ws + OFF_HLOC) + tokb * 1024 + c0;
  u16* pcum = (u16*)(ws + OFF_PCUM) + tokb * 1024 + c0;
  s16x8 fa[4], fx[4];
  {
    const u16* wa = (const u16*)(ws + OFF_LWA_T) + (size_t)nb * 4096 + (tn * 32 + (lane & 31)) * 64 + (lane >> 5) * 8;
    const u16* wx = (const u16*)(ws + OFF_LWX_T) + (size_t)nb * 4096 + (tn * 32 + (lane & 31)) * 64 + (lane >> 5) * 8;
#pragma unroll
    for (int ks = 0; ks < 4; ++ks) { fa[ks] = *(const s16x8*)(wa + ks * 16); fx[ks] = *(const s16x8*)(wx + ks * 16); }
  }
  const int jch = tn * 32 + (lane & 31);
  const float ba_j = P.lru_ba[c0 + jch], bx_j = P.lru_bx[c0 + jch];
  float sp_j;
  {
    float nl = -P.lru_lambda[c0 + jch];
    sp_j = fmaxf(nl, 0.f) + log1pf(__expf(-fabsf(nl)));
  }
  const int cch = tid & 63, seg = tid >> 6;
  const float cw0 = P.conv_w[0 * 1024 + c0 + cch], cw1 = P.conv_w[1 * 1024 + c0 + cch], cw2 = P.conv_w[2 * 1024 + c0 + cch],
              cw3 = P.conv_w[3 * 1024 + c0 + cch], cbb = P.conv_b[c0 + cch];
  __syncthreads();
  if (tid < 64) { sHg[tid] = 0.f; sPg[tid] = 1.f; }
  float hlast = 0.f, plast = 1.f;
  u32x4 pf[3];
#pragma unroll
  for (int i = 0; i < 3; ++i) {
    const int id = tid + 256 * i, r = id >> 3, c8 = (id & 7) * 8, t = grp4 * 256 - 3 + r;
    pf[i] = u32x4{0u, 0u, 0u, 0u};
    if (id < 67 * 8 && t >= 0) pf[i] = *(const u32x4*)(zxr + (size_t)t * 1024 + c8);
  }
#pragma unroll 1
  for (int ck = grp4 * 4; ck < grp4 * 4 + 4; ++ck) {
  const int t0 = ck * 64;
  __syncthreads();
#pragma unroll
  for (int i = 0; i < 3; ++i) {
    const int id = tid + 256 * i, r = id >> 3, c8 = (id & 7) * 8;
    if (id < 67 * 8) {
#pragma unroll
      for (int j = 0; j < 4; ++j) { sXr[r * 65 + c8 + 2 * j] = bflo(pf[i][j]); sXr[r * 65 + c8 + 2 * j + 1] = bfhi(pf[i][j]); }
    }
  }
  if (ck + 1 < grp4 * 4 + 4) {
#pragma unroll
    for (int i = 0; i < 3; ++i) {
      const int id = tid + 256 * i, r = id >> 3, c8 = (id & 7) * 8, t = t0 + 64 - 3 + r;
      if (id < 67 * 8) pf[i] = *(const u32x4*)(zxr + (size_t)t * 1024 + c8);
    }
  }
  __syncthreads();
#pragma unroll
  for (int e = 0; e < 16; ++e) {
    int t = seg * 16 + e;
    float xc = cbb + cw0 * sXr[t * 65 + cch] + cw1 * sXr[(t + 1) * 65 + cch] + cw2 * sXr[(t + 2) * 65 + cch] +
               cw3 * sXr[(t + 3) * 65 + cch];
    sXc[t * 65 + cch] = xc;
    sA[t * 72 + cch] = f2bf(xc);
  }
  __syncthreads();
  f32x16 racc = zero16(), iacc = zero16();
#pragma unroll
  for (int ks = 0; ks < 4; ++ks) {
    s16x8 a = *(const s16x8*)(sA + (tm * 32 + (lane & 31)) * 72 + ks * 16 + (lane >> 5) * 8);
    racc = mfma32(a, fa[ks], racc);
    iacc = mfma32(a, fx[ks], iacc);
  }
#pragma unroll
  for (int i = 0; i < 16; ++i) {
    int t = tm * 32 + (i >> 2) * 8 + (lane >> 5) * 4 + (i & 3);
    float rr = sigmoidf_(racc[i] + ba_j);
    float ii = sigmoidf_(iacc[i] + bx_j);
    float log_a = -8.0f * rr * sp_j;
    float a = __expf(log_a);
    float mult = __builtin_amdgcn_sqrtf(fmaxf(1.0f - __expf(2.0f * log_a), 0.f));
    sAa[t * 65 + jch] = a;
    sBb[t * 65 + jch] = mult * ii * sXc[t * 65 + jch];
  }
  __syncthreads();
  float hl[16], pl[16];
  {
    float h = 0.f, p = 1.f;
#pragma unroll
    for (int e = 0; e < 16; ++e) {
      int t = seg * 16 + e;
      float a = sAa[t * 65 + cch], b = sBb[t * 65 + cch];
      h = a * h + b;
      p *= a;
      hl[e] = h;
      pl[e] = p;
    }
    sSegA[seg * 64 + cch] = p;
    sSegH[seg * 64 + cch] = h;
  }
  __syncthreads();
  float cin = sHg[cch], pin = sPg[cch];
  for (int s2 = 0; s2 < seg; ++s2) {
    cin = sSegA[s2 * 64 + cch] * cin + sSegH[s2 * 64 + cch];
    pin *= sSegA[s2 * 64 + cch];
  }
#pragma unroll
  for (int e = 0; e < 16; ++e) {
    const size_t t = (size_t)(t0 + seg * 16 + e);
    hlast = hl[e] + pl[e] * cin;
    plast = pl[e] * pin;
    hloc[t * 1024 + cch] = f2bf(hlast);
    pcum[t * 1024 + cch] = f2bf(plast);
  }
  __syncthreads();
  if (seg == 3) { sHg[cch] = hlast; sPg[cch] = plast; }
  }
  if (seg == 3) {
    float* sumA = (float*)(ws + OFF_SUMA) + ((size_t)b_local * 16 + grp4) * 1024 + c0;
    float* sumH = (float*)(ws + OFF_SUMH) + ((size_t)b_local * 16 + grp4) * 1024 + c0;
    sumA[cch] = plast;
    sumH[cch] = hlast;
  }
}

__device__ void phase_mixers(const Params& P, int g, int cslot, unsigned char* smem) {
  unsigned char* ws = P.ws;
  __shared__ int s_item;
  unsigned* ctr = (unsigned*)(ws + OFF_CTR) + g + cslot;
  constexpr int N_LRU = BPG * 16 * 16;
  constexpr int N_DSWA = BPG * 3 * 4 * 32;
  constexpr int N_MEM = BPG * 4 * 32;
  constexpr int N_ALL = N_LRU + N_DSWA + N_MEM;
  const u16* zq = (const u16*)(ws + OFF_ZQ);
  const u16* zk = (const u16*)(ws + OFF_ZK);
  const u16* zv = (const u16*)(ws + OFF_ZV);
  (void)ctr; (void)s_item;
  for (int it0 = blockIdx.x; it0 < N_ALL; it0 += gridDim.x) {
    int it = it0;
    if (it < N_LRU) {
      lru_chunk_item(P, it >> 8, (it >> 4) & 15, it & 15, smem);
    } else {
      const u16 *Q, *Ka, *Va, *Kb2, *Vb2;
      u16* O;
      float* L;
      size_t qs, kvs, os, lses;
      int mode0, mode1;
      if (it < N_LRU + N_DSWA) {
        int u = it - N_LRU;
        const int blk = u & 31; u >>= 5;
        const int h = u & 3; u >>= 2;
        const int grp = u % 3; const int bl = u / 3;
        const int dl = (grp == 0) ? 1 : (grp == 1 ? 4 : 16);
        const int r = blk % dl, n = blk / dl;
        const size_t tok0 = (size_t)bl * SEQ + (size_t)(n * 128) * dl + r;
        const size_t colo = (size_t)grp * 512 + h * 128;
        const size_t rs = (size_t)dl * 1536;
        Q = zq + tok0 * 1536 + colo;
        Ka = zk + tok0 * 1536 + colo;
        Va = zv + tok0 * 1536 + colo;
        Kb2 = (n > 0) ? Ka - (size_t)128 * rs : Ka;
        Vb2 = (n > 0) ? Va - (size_t)128 * rs : Va;
        O = (u16*)(ws + OFF_OG) + ((size_t)grp * TG + tok0) * 512 + h * 128;
        L = (float*)(ws + OFF_LSE) + ((size_t)grp * TG + tok0) * 4 + h;
        qs = rs; kvs = rs; os = (size_t)dl * 512; lses = (size_t)dl * 4;
        mode0 = 1; mode1 = (n > 0) ? 2 : -1;
      } else {
        int u = it - N_LRU - N_DSWA;
        const int blk = u & 31; u >>= 5;
        const int h = u & 3; const int bl = u >> 2;
        const int b = g * BPG + bl;
        const size_t tok0 = (size_t)bl * SEQ + blk * 128;
        Q = (const u16*)(ws + OFF_ZMQ) + tok0 * 512 + h * 128;
        Ka = (const u16*)(ws + OFF_MEMKV) + (size_t)b * 256 * 1024 + h * 128;
        Va = Ka + 512;
        Kb2 = Ka + (size_t)128 * 1024;
        Vb2 = Va + (size_t)128 * 1024;
        O = (u16*)(ws + OFF_MEMO) + tok0 * 512 + h * 128;
        L = nullptr;
        qs = 512; kvs = 1024; os = 512; lses = 0;
        mode0 = 0; mode1 = 0;
      }
      attn_block(Q, qs, Ka, Va, mode0, Kb2, Vb2, mode1, kvs, O, os, L, lses, (u16*)smem);
    }
  }
}

__device__ void phase_combine(const Params& P) {
  unsigned char* ws = P.ws;
  const u16* og = (const u16*)(ws + OFF_OG);
  const float* lse = (const float*)(ws + OFF_LSE);
  u16* attn = (u16*)(ws + OFF_ATTN);
  const size_t n = (size_t)TG * 64;
  for (size_t idx = (size_t)blockIdx.x * 256 + otid(); idx < n; idx += (size_t)gridDim.x * 256) {
    const size_t row = idx >> 6;
    const int k = (int)(idx & 63) * 8, h = k >> 7;
    float l0 = lse[row * 4 + h], l1 = lse[((size_t)TG + row) * 4 + h], l2 = lse[((size_t)2 * TG + row) * 4 + h];
    float m = fmaxf(l0, fmaxf(l1, l2));
    float e0 = __expf(l0 - m), e1 = __expf(l1 - m), e2 = __expf(l2 - m);
    float inv = 1.0f / (e0 + e1 + e2);
    e0 *= inv; e1 *= inv; e2 *= inv;
    u32x4 a = *(const u32x4*)(og + row * 512 + k);
    u32x4 b = *(const u32x4*)(og + ((size_t)TG + row) * 512 + k);
    u32x4 c = *(const u32x4*)(og + ((size_t)2 * TG + row) * 512 + k);
    u32x4 o;
#pragma unroll
    for (int j = 0; j < 4; ++j)
      o[j] = pack2(e0 * bflo(a[j]) + e1 * bflo(b[j]) + e2 * bflo(c[j]), e0 * bfhi(a[j]) + e1 * bfhi(b[j]) + e2 * bfhi(c[j]));
    *(u32x4*)(attn + row * 512 + k) = o;
  }
  {
    const float* sumA = (const float*)(ws + OFF_SUMA);
    const float* sumH = (const float*)(ws + OFF_SUMH);
    const u16* hloc = (const u16*)(ws + OFF_HLOC);
    const u16* pcum = (const u16*)(ws + OFF_PCUM);
    const u16* zyg = (const u16*)(ws + OFF_ZYG);
    u16* rec = (u16*)(ws + OFF_REC);
    for (int gid = blockIdx.x * 256 + otid(); gid < BPG * 64 * 8 * 128; gid += gridDim.x * 256) {
      const int c8 = (gid & 127) * 8, qt = (gid >> 7) & 7, k = (gid >> 10) & 63, bl = gid >> 16;
      float carry[8];
#pragma unroll
      for (int j = 0; j < 8; ++j) carry[j] = 0.f;
      for (int j = 0; j < (k >> 2); ++j) {
        const size_t o = ((size_t)bl * 16 + j) * 1024 + c8;
        const f32x4 a0 = *(const f32x4*)(sumA + o), a1 = *(const f32x4*)(sumA + o + 4);
        const f32x4 h0 = *(const f32x4*)(sumH + o), h1 = *(const f32x4*)(sumH + o + 4);
#pragma unroll
        for (int e = 0; e < 4; ++e) { carry[e] = a0[e] * carry[e] + h0[e]; carry[4 + e] = a1[e] * carry[4 + e] + h1[e]; }
      }
      const size_t base = ((size_t)bl * SEQ + (size_t)k * 64 + qt * 8) * 1024 + c8;
#pragma unroll 4
      for (int t = 0; t < 8; ++t) {
        const size_t o = base + (size_t)t * 1024;
        const u32x4 hv = *(const u32x4*)(hloc + o), pv = *(const u32x4*)(pcum + o), yv = *(const u32x4*)(zyg + o);
        u32x4 r;
#pragma unroll
        for (int e = 0; e < 4; ++e) {
          const float h0 = bflo(hv[e]) + bflo(pv[e]) * carry[2 * e];
          const float h1 = bfhi(hv[e]) + bfhi(pv[e]) * carry[2 * e + 1];
          r[e] = pack2(h0 * gelu_tanh(bflo(yv[e])), h1 * gelu_tanh(bfhi(yv[e])));
        }
        *(u32x4*)(rec + o) = r;
      }
    }
  }
}

__device__ void phase_merge(const Params& P, int g, unsigned char* smem) {
  unsigned char* ws = P.ws;
  constexpr int NRT = TG / 128, NCT = 8;
  const u16* gates = (const u16*)(ws + ((g & 1) ? OFF_GATES2 : OFF_GATES));
  u16* merged = (u16*)(ws + OFF_MERGED) + (size_t)g * TG * 1024;
  for (int t = blockIdx.x; t < NRT * NCT; t += gridDim.x) {
    const int ct = t / NRT, rt = t % NRT;
    const size_t row0 = (size_t)rt * 128;
    f32x16 acc[2][2];
    f32x4 m2[8][2];
#pragma unroll
    for (int it = 0; it < 8; ++it) { m2[it][0] = (f32x4)(0.f); m2[it][1] = (f32x4)(0.f); }
    const float* sC = (const float*)smem;
#pragma unroll 1
    for (int br = 0; br < 3; ++br) {
      acc_zero(acc);
      {
        const u16* Ap = (br == 0) ? (const u16*)(ws + OFF_ATTN) + row0 * 512
                      : (br == 1) ? (const u16*)(ws + OFF_REC) + row0 * 1024 : (const u16*)(ws + OFF_MEMO) + row0 * 512;
        const unsigned kk = (br == 1) ? 1024u : 512u;
        const u16* Bp = (br == 0) ? (const u16*)(ws + OFF_WBA_T) : (br == 1) ? (const u16*)(ws + OFF_WBL_T) : (const u16*)(ws + OFF_WBM_T);
        LoadBf16 la{Ap, kk, 0};
        gemm_mainloop_t<2, LoadBf16>(acc, la, Bp + (size_t)ct * 128 * kk, kk, (int)kk, (u16*)smem);
      }
      acc_to_lds(acc, (float*)smem);
#pragma unroll
      for (int it = 0; it < 8; ++it) {
        const int idx = otid() + 256 * it, row = idx >> 4, c8 = (idx & 15) * 8;
        f32x4 v0 = *(const f32x4*)(sC + row * 132 + c8), v1 = *(const f32x4*)(sC + row * 132 + c8 + 4);
        u32x4 gt = *(const u32x4*)(gates + (row0 + row) * 3072 + br * 1024 + ct * 128 + c8);
        m2[it][0].x += bflo(gt.x) * v0.x; m2[it][0].y += bfhi(gt.x) * v0.y;
        m2[it][0].z += bflo(gt.y) * v0.z; m2[it][0].w += bfhi(gt.y) * v0.w;
        m2[it][1].x += bflo(gt.z) * v1.x; m2[it][1].y += bfhi(gt.z) * v1.y;
        m2[it][1].z += bflo(gt.w) * v1.z; m2[it][1].w += bfhi(gt.w) * v1.w;
      }
    }
#pragma unroll
    for (int it = 0; it < 8; ++it) {
      const int idx = otid() + 256 * it, row = idx >> 4, c8 = (idx & 15) * 8;
      *(u32x4*)(merged + (row0 + row) * 1024 + ct * 128 + c8) = pack8(m2[it][0], m2[it][1]);
    }
  }
}

template <int H2>
__device__ __forceinline__ void outproj_store_half(const Params& P, f32x16 (&acc)[2][4], unsigned char* smem, u16* y,
                                                   size_t row0, int cb0) {
  acc_to_lds_wide<H2>(acc, (float*)smem);
  const float* sC = (const float*)smem;
  const float* x = P.x;
  const int cb = cb0 + H2 * 128;
#pragma unroll 2
  for (int it = 0; it < 8; ++it) {
    const int idx = otid() + 256 * it, row = idx >> 4, c8 = (idx & 15) * 8;
    f32x4 v0 = *(const f32x4*)(sC + row * 132 + c8), v1 = *(const f32x4*)(sC + row * 132 + c8 + 4);
    const size_t o = (row0 + row) * 1024 + cb + c8;
    f32x4 x0 = *(const f32x4*)(x + o), x1 = *(const f32x4*)(x + o + 4);
    *(u32x4*)(y + o) = pack8(ALPHA * x0 + v0, ALPHA * x1 + v1);
  }
}
__device__ void phase_outproj(const Params& P, unsigned char* smem) {
  unsigned char* ws = P.ws;
  constexpr int NRT = T_TOK / 128, NCT = 4;
  const u16* merged = (const u16*)(ws + OFF_MERGED);
  u16* y = (u16*)(ws + OFF_Y);
  for (int t = blockIdx.x; t < NRT * NCT; t += gridDim.x) {
    const int ct = t / NRT, rt = t % NRT;
    const size_t row0 = (size_t)rt * 128;
    f32x16 acc[2][4];
#pragma unroll
    for (int mi = 0; mi < 2; ++mi)
#pragma unroll
      for (int ni = 0; ni < 4; ++ni) acc[mi][ni] = zero16();
    LoadBf16 la{merged + row0 * 1024, 1024, 0};
    gemm_mainloop_wide(acc, la, (const u16*)(ws + OFF_WOUT_T) + (size_t)ct * 256 * 1024, 1024, 1024, (u16*)smem);
    outproj_store_half<0>(P, acc, smem, y, row0, ct * 256);
    outproj_store_half<1>(P, acc, smem, y, row0, ct * 256);
  }
}

__device__ void phase_ln1(const Params& P) {
  unsigned char* ws = P.ws;
  const u16* y = (const u16*)(ws + OFF_Y);
  u16* x1b = (u16*)(ws + OFF_XB);
  const int lane = otid() & 63;
  const int gw = blockIdx.x * 4 + (otid() >> 6), nw = gridDim.x * 4;
  for (int row = gw; row < T_TOK; row += nw) {
    const u16* yr = y + (size_t)row * 1024 + lane * 16;
    const u32x4 r0 = *(const u32x4*)yr, r1 = *(const u32x4*)(yr + 8);
    float v[16];
#pragma unroll
    for (int j = 0; j < 4; ++j) {
      v[2 * j] = bflo(r0[j]); v[2 * j + 1] = bfhi(r0[j]);
      v[8 + 2 * j] = bflo(r1[j]); v[8 + 2 * j + 1] = bfhi(r1[j]);
    }
    float s = 0.f;
#pragma unroll
    for (int j = 0; j < 16; ++j) s += v[j];
    const float mu = wave_sum(s) * (1.0f / 1024.0f);
    float q = 0.f;
#pragma unroll
    for (int j = 0; j < 16; ++j) { v[j] -= mu; q += v[j] * v[j]; }
    const float rstd = rsqrtf(wave_sum(q) * (1.0f / 1024.0f) + LN_EPS);
    u32x4 o0, o1;
#pragma unroll
    for (int q4 = 0; q4 < 4; ++q4) {
      const int c = lane * 16 + 4 * q4;
      const f32x4 gg = *(const f32x4*)(P.ln1_g + c), bb = *(const f32x4*)(P.ln1_b + c);
      const unsigned lo = pack2(v[4 * q4] * rstd * gg.x + bb.x, v[4 * q4 + 1] * rstd * gg.y + bb.y);
      const unsigned hi = pack2(v[4 * q4 + 2] * rstd * gg.z + bb.z, v[4 * q4 + 3] * rstd * gg.w + bb.w);
      if (q4 < 2) { o0[2 * q4] = lo; o0[2 * q4 + 1] = hi; } else { o1[2 * (q4 - 2)] = lo; o1[2 * (q4 - 2) + 1] = hi; }
    }
    *(u32x4*)(x1b + (size_t)row * 1024 + lane * 16) = o0;
    *(u32x4*)(x1b + (size_t)row * 1024 + lane * 16 + 8) = o1;
  }
}

template <int H2>
__device__ __forceinline__ void peerq_store_half(f32x16 (&acc)[2][4], unsigned char* smem, u16* pq, size_t row0, int cb0) {
  acc_to_lds_wide<H2>(acc, (float*)smem);
  const float* sC = (const float*)smem;
  const int cb = cb0 + H2 * 128;
#pragma unroll 2
  for (int it = 0; it < 8; ++it) {
    const int idx = otid() + 256 * it, row = idx >> 4, c8 = (idx & 15) * 8;
    f32x4 v0 = *(const f32x4*)(sC + row * 132 + c8), v1 = *(const f32x4*)(sC + row * 132 + c8 + 4);
    *(u32x4*)(pq + (row0 + row) * 2048 + cb + c8) = pack8(v0, v1);
  }
}
__device__ void phase_peerq(const Params& P, unsigned char* smem) {
  unsigned char* ws = P.ws;
  constexpr int NRT = T_TOK / 128, NCT = 8;
  const u16* x1b = (const u16*)(ws + OFF_XB);
  u16* pq = (u16*)(ws + OFF_PQ);
  for (int t = blockIdx.x; t < NRT * NCT; t += gridDim.x) {
    const int ct = t / NRT, rt = t % NRT;
    const size_t row0 = (size_t)rt * 128;
    f32x16 acc[2][4];
#pragma unroll
    for (int mi = 0; mi < 2; ++mi)
#pragma unroll
      for (int ni = 0; ni < 4; ++ni) acc[mi][ni] = zero16();
    LoadBf16 la{x1b + row0 * 1024, 1024, 0};
    gemm_mainloop_wide(acc, la, (const u16*)(ws + OFF_WQ_T) + (size_t)ct * 256 * 1024, 1024, 1024, (u16*)smem);
    peerq_store_half<0>(acc, smem, pq, row0, ct * 256);
    peerq_store_half<1>(acc, smem, pq, row0, ct * 256);
  }
}

__device__ void phase_scores(const Params& P, unsigned char* smem) {
  unsigned char* ws = P.ws;
  constexpr int NRT = T_TOK / 128, NHP = 16;
  const u16* pq = (const u16*)(ws + OFF_PQ);
  float* stop = (float*)(ws + OFF_STOP);
  unsigned char* itop = (unsigned char*)(ws + OFF_ITOP);
  float* sS = (float*)smem;
  const int lane = otid() & 63, w = otid() >> 6;
  for (int t = blockIdx.x; t < NRT * NHP; t += gridDim.x) {
    const int hp = t / NRT, rt = t % NRT;
    const size_t row0 = (size_t)rt * 128;
    f32x16 acc[2][2];
    acc_zero(acc);
    LoadBf16 la{pq + row0 * 2048 + hp * 128, 2048, 0};
    gemm_mainloop(acc, la, (const u16*)(ws + OFF_KEYS) + (size_t)hp * 128 * 128, 128, 128, (u16*)smem);
    acc_to_lds(acc, sS);
    {
      const int row = w * 32 + (lane & 31), hh = lane >> 5;
      const float* src = sS + row * 132 + hh * 64;
#define CE_DESC(x_, y_) { const unsigned hi_ = max(x_, y_), lo_ = min(x_, y_); x_ = hi_; y_ = lo_; }
#define BSTAGE(ARR, KK, JJ)                                                          \
      _Pragma("unroll") for (int i = 0; i < 16; ++i) {                                \
        if ((i ^ (JJ)) > i) {                                                         \
          if ((i & (KK)) == 0) CE_DESC(ARR[i], ARR[i ^ (JJ)])                         \
          else CE_DESC(ARR[i ^ (JJ)], ARR[i])                                         \
        }                                                                             \
      }
#define MERGE16(ARR) BSTAGE(ARR, 16, 8) BSTAGE(ARR, 16, 4) BSTAGE(ARR, 16, 2) BSTAGE(ARR, 16, 1)
#define SORT16(ARR) BSTAGE(ARR, 2, 1) BSTAGE(ARR, 4, 2) BSTAGE(ARR, 4, 1) BSTAGE(ARR, 8, 4) BSTAGE(ARR, 8, 2) BSTAGE(ARR, 8, 1) MERGE16(ARR)
      unsigned L[16], LB[16], LC[16], LD[16];
#pragma unroll
      for (int q = 0; q < 4; ++q) {
        const f32x4 va = *(const f32x4*)(src + 4 * q), vb = *(const f32x4*)(src + 16 + 4 * q);
        const f32x4 vc = *(const f32x4*)(src + 32 + 4 * q), vd = *(const f32x4*)(src + 48 + 4 * q);
#pragma unroll
        for (int e = 0; e < 4; ++e) {
          const int p = 4 * q + e;
          L[p] = (f2ord(va[e]) & 0xFFFFFF80u) | (unsigned)(127 - (hh * 64 + p));
          LB[p] = (f2ord(vb[e]) & 0xFFFFFF80u) | (unsigned)(127 - (hh * 64 + 16 + p));
          LC[p] = (f2ord(vc[e]) & 0xFFFFFF80u) | (unsigned)(127 - (hh * 64 + 32 + p));
          LD[p] = (f2ord(vd[e]) & 0xFFFFFF80u) | (unsigned)(127 - (hh * 64 + 48 + p));
        }
      }
      SORT16(L) SORT16(LB) SORT16(LC) SORT16(LD)
#pragma unroll
      for (int i = 0; i < 16; ++i) { L[i] = max(L[i], LB[15 - i]); LC[i] = max(LC[i], LD[15 - i]); }
      MERGE16(L) MERGE16(LC)
#pragma unroll
      for (int i = 0; i < 16; ++i) L[i] = max(L[i], LC[15 - i]);
      MERGE16(L)
      unsigned M[16];
#pragma unroll
      for (int i = 0; i < 16; ++i) {
        const unsigned pv = (unsigned)__shfl_xor((int)L[15 - i], 32, 64);
        M[i] = max(L[i], pv);
      }
      MERGE16(M)
#undef SORT16
#undef MERGE16
#undef BSTAGE
#undef CE_DESC
      float sc[8];
      unsigned ib[2] = {0u, 0u};
#pragma unroll
      for (int i = 0; i < 8; ++i) {
        const unsigned hmask = 0u - (unsigned)hh;
        const unsigned mk = (M[8 + i] & hmask) | (M[i] & ~hmask);
        const int idx = 127 - (int)(mk & 127u);
        sc[i] = sS[row * 132 + idx];
        ib[i >> 2] |= (unsigned)idx << (8 * (i & 3));
      }
      const size_t o = ((row0 + row) * 16 + hp) * 16 + hh * 8;
      f32x4 o0 = {sc[0], sc[1], sc[2], sc[3]}, o1 = {sc[4], sc[5], sc[6], sc[7]};
      *(f32x4*)(stop + o) = o0;
      *(f32x4*)(stop + o + 4) = o1;
      u32x2 ob = {ib[0], ib[1]};
      *(u32x2*)(itop + o) = ob;
    }
  }
}

__device__ __forceinline__ void peer_load8(const u32x4* myE, int e0, int lane, const unsigned char* ub, const unsigned char* vb,
                                           u32x4& rec, u32x4 (&uq)[8], u32x2 (&vq)[8]) {
  rec = myE[e0 + (lane & 7)];
#pragma unroll
  for (int q = 0; q < 8; ++q) {
    const int id = __builtin_amdgcn_readlane((int)rec.x, q);
    uq[q] = *(const u32x4*)(ub + (size_t)id * 1024 + lane * 16);
    vq[q] = *(const u32x2*)(vb + (size_t)id * 512 + lane * 8);
  }
}
__device__ __forceinline__ void peer_eval8(int lane, const u32x4& rec, const u32x4 (&uq)[8], const u32x2 (&vq)[8],
                                           const f32x2 (&xv2)[8], f32x2 (&facc2)[8]) {
  float dl = 0.f;
#pragma unroll
  for (int q = 0; q < 8; ++q) {
    f32x2 d2 = f32x2{0.f, 0.f};
#pragma unroll
    for (int j = 0; j < 4; ++j) {
      const f32x2 lo = __builtin_amdgcn_cvt_pk_f32_fp8((int)uq[q][j], false);
      const f32x2 hi = __builtin_amdgcn_cvt_pk_f32_fp8((int)uq[q][j], true);
      d2 += lo * xv2[2 * j];
      d2 += hi * xv2[2 * j + 1];
    }
    const float d = wave_sum(d2.x + d2.y);
    dl = ((lane & 7) == q) ? d : dl;
  }
  const float cfl = __uint_as_float(rec.y) * gelu_erf(dl * __uint_as_float(rec.z));
#pragma unroll
  for (int q = 0; q < 8; ++q) {
    const float cf = __builtin_bit_cast(float, __builtin_amdgcn_readlane(__builtin_bit_cast(int, cfl), q));
    const f32x2 cf2 = f32x2{cf, cf};
#pragma unroll
    for (int wd = 0; wd < 2; ++wd) {
      facc2[4 * wd + 0] += cf2 * __builtin_amdgcn_cvt_scalef32_pk_f32_fp4(vq[q][wd], 1.0f, 0);
      facc2[4 * wd + 1] += cf2 * __builtin_amdgcn_cvt_scalef32_pk_f32_fp4(vq[q][wd], 1.0f, 1);
      facc2[4 * wd + 2] += cf2 * __builtin_amdgcn_cvt_scalef32_pk_f32_fp4(vq[q][wd], 1.0f, 2);
      facc2[4 * wd + 3] += cf2 * __builtin_amdgcn_cvt_scalef32_pk_f32_fp4(vq[q][wd], 1.0f, 3);
    }
  }
}

__device__ void phase_experts(const Params& P, unsigned char* smem) {
  unsigned char* ws = P.ws;
  const u16* x1 = (const u16*)(ws + OFF_XB);
  const float* stop = (const float*)(ws + OFF_STOP);
  const unsigned char* itop = (const unsigned char*)(ws + OFF_ITOP);
  const unsigned char* ub = ws + OFF_UB;
  const unsigned char* vb = ws + OFF_VB;
  const float* uscale = (const float*)(ws + OFF_UB + (size_t)16384 * 1024);
  const float* vscale = (const float*)(ws + OFF_VB + (size_t)16384 * 1024);
  const int tid = otid(), lane = tid & 63, w = tid >> 6;
  u32x4* sE = (u32x4*)smem;
  for (int tb = blockIdx.x; tb < T_TOK / 32; tb += gridDim.x) {
    __syncthreads();
    {
      const int tl = tid >> 3, h = tid & 7;
      const size_t tok = (size_t)tb * 32 + tl;
      const size_t ba = (tok * 16 + h * 2) * 16, bb = ba + 16;
      float sa[16], sb[16];
#pragma unroll
      for (int q = 0; q < 4; ++q) {
        f32x4 va = *(const f32x4*)(stop + ba + 4 * q), vb4 = *(const f32x4*)(stop + bb + 4 * q);
#pragma unroll
        for (int e = 0; e < 4; ++e) { sa[4 * q + e] = va[e]; sb[4 * q + e] = vb4[e]; }
      }
      unsigned L[16];
#pragma unroll
      for (int j = 0; j < 16; ++j) L[j] = 0u;
#pragma unroll
      for (int k1 = 0; k1 < 16; ++k1) {
#pragma unroll
        for (int k2 = 0; k2 < 16; ++k2) {
          if ((k1 + 1) * (k2 + 1) <= 16) {
            const unsigned key = (f2ord(sa[k1] + sb[k2]) & 0xFFFFFF00u) | (unsigned)(255 - (k1 * 16 + k2));
            TOPK_INSERT(L, key);
          }
        }
      }
      const float m0 = ord2f(L[0] & 0xFFFFFF00u);
      float ev[16], ssum = 0.f;
#pragma unroll
      for (int i = 0; i < 16; ++i) { ev[i] = __expf(ord2f(L[i] & 0xFFFFFF00u) - m0); ssum += ev[i]; }
      const float inv = 1.0f / ssum;
#pragma unroll
      for (int i = 0; i < 16; ++i) {
        const int flat = 255 - (int)(L[i] & 255u);
        const int ia = itop[ba + (flat >> 4)], ib = itop[bb + (flat & 15)];
        const int id = ia * 128 + ib;
        u32x4 rec = {(unsigned)id, __float_as_uint(ev[i] * inv * vscale[id]), __float_as_uint(uscale[id]), 0u};
        sE[tl * 128 + h * 16 + i] = rec;
      }
    }
    __syncthreads();
    for (int tt = 0; tt < 8; ++tt) {
      const int tl = w * 8 + tt;
      const size_t tok = (size_t)tb * 32 + tl;
      f32x2 xv2[8];
      {
        const u16* xr = x1 + tok * 1024 + lane * 16;
        const u32x4 r0 = *(const u32x4*)xr, r1 = *(const u32x4*)(xr + 8);
#pragma unroll
        for (int j = 0; j < 4; ++j) {
          xv2[j] = f32x2{bflo(r0[j]), bfhi(r0[j])};
          xv2[4 + j] = f32x2{bflo(r1[j]), bfhi(r1[j])};
        }
      }
      f32x2 facc2[8];
#pragma unroll
      for (int j = 0; j < 8; ++j) facc2[j] = f32x2{0.f, 0.f};
      const u32x4* myE = sE + tl * 128;
      {
        u32x4 recA, recB, uqA[8], uqB[8];
        u32x2 vqA[8], vqB[8];
        peer_load8(myE, 0, lane, ub, vb, recA, uqA, vqA);
#pragma unroll 1
        for (int e0 = 0; e0 < 128; e0 += 16) {
          peer_load8(myE, e0 + 8, lane, ub, vb, recB, uqB, vqB);
          peer_eval8(lane, recA, uqA, vqA, xv2, facc2);
          if (e0 + 16 < 128) peer_load8(myE, e0 + 16, lane, ub, vb, recA, uqA, vqA);
          peer_eval8(lane, recB, uqB, vqB, xv2, facc2);
        }
      }
      float xv[16], facc[16];
#pragma unroll
      for (int j = 0; j < 8; ++j) { xv[2 * j] = xv2[j].x; xv[2 * j + 1] = xv2[j].y; facc[2 * j] = facc2[j].x; facc[2 * j + 1] = facc2[j].y; }
      float sm = 0.f;
#pragma unroll
      for (int j = 0; j < 16; ++j) { xv[j] = ALPHA * xv[j] + facc[j]; sm += xv[j]; }
      const float mu = wave_sum(sm) * (1.0f / 1024.0f);
      float q2 = 0.f;
#pragma unroll
      for (int j = 0; j < 16; ++j) { xv[j] -= mu; q2 += xv[j] * xv[j]; }
      const float rstd = rsqrtf(wave_sum(q2) * (1.0f / 1024.0f) + LN_EPS);
      float* orow = P.out + tok * 1024 + lane * 16;
#pragma unroll
      for (int q = 0; q < 4; ++q) {
        const int c = lane * 16 + 4 * q;
        f32x4 gg = *(const f32x4*)(P.ln2_g + c), bb2 = *(const f32x4*)(P.ln2_b + c);
        f32x4 o;
#pragma unroll
        for (int j = 0; j < 4; ++j) o[j] = xv[4 * q + j] * rstd * gg[j] + bb2[j];
        *(f32x4*)(orow + 4 * q) = o;
      }
    }
  }
}

#define XB_TMO      128
#define XB_XCNT(j)  (256  + 64 * (j))
#define XB_XSUB(j)  (1280 + 64 * (j))
#define XB_XGEN(j)  (2304 + 64 * (j))
#define XB_TOP      3328
#define XB_TOPGEN   3392
#define XB_SPIN_CAP (1u << 22)
__device__ __forceinline__ unsigned xb_ld(unsigned* p) { return __hip_atomic_load(p, __ATOMIC_RELAXED, __HIP_MEMORY_SCOPE_AGENT); }
__device__ __forceinline__ unsigned xb_add(unsigned* p, unsigned v) { return __hip_atomic_fetch_add(p, v, __ATOMIC_RELAXED, __HIP_MEMORY_SCOPE_AGENT); }
__device__ __forceinline__ unsigned xb_xcc_id() { return (unsigned)__builtin_amdgcn_s_getreg((3 << 11) | 20) & 0xFu; }
#define XB_SPIN(cond, bar) do { unsigned _sp = 0; while (cond) { __builtin_amdgcn_s_sleep(1); \
    if ((++_sp & 255u) == 0u) { if (xb_ld(&(bar)[XB_TMO])) break; if (_sp > XB_SPIN_CAP) { atomicAdd(&(bar)[XB_TMO], 1u); break; } } } } while (0)

__device__ __forceinline__ void grid_barrier(unsigned* bar, unsigned xcc, volatile unsigned* st) {
  asm volatile("s_waitcnt vmcnt(0)" ::: "memory");
  __syncthreads();
  if (threadIdx.x == 0) {
    __builtin_amdgcn_s_waitcnt(0);
    unsigned nloc = st[0], nx = st[1];
    if (nloc == 0u) {
      const unsigned G = gridDim.x;
      unsigned sum, cnt, mine, sp = 0u;
      for (;;) {
        sum = 0u; cnt = 0u; mine = 0u;
#pragma unroll
        for (unsigned j = 0; j < 16; ++j) { const unsigned c = xb_ld(&bar[XB_XCNT(j)]); sum += c; cnt += (c > 0u) ? 1u : 0u; mine = (j == xcc) ? c : mine; }
        if (sum == G) break;
        __builtin_amdgcn_s_sleep(1);
        if ((++sp & 255u) == 0u) { if (xb_ld(&bar[XB_TMO])) break; if (sp > XB_SPIN_CAP) { atomicAdd(&bar[XB_TMO], 1u); break; } }
      }
      nloc = mine > 0u ? mine : 1u; nx = cnt > 0u ? cnt : 1u;
      st[0] = nloc; st[1] = nx;
    }
    const unsigned old = xb_add(&bar[XB_XSUB(xcc)], 1u);
    const unsigned gen = old / nloc;
    if (old + 1u == (gen + 1u) * nloc) {
      __builtin_amdgcn_fence(__ATOMIC_RELEASE, "agent");
      asm volatile("s_waitcnt vmcnt(0)" ::: "memory");
      const unsigned og = xb_add(&bar[XB_TOP], 1u);
      const unsigned tg = og / nx;
      if (og + 1u == (tg + 1u) * nx) xb_add(&bar[XB_TOPGEN], 1u);
      else XB_SPIN(xb_ld(&bar[XB_TOPGEN]) == tg, bar);
      __builtin_amdgcn_fence(__ATOMIC_ACQUIRE, "agent");
      xb_add(&bar[XB_XGEN(xcc)], 1u);
      asm volatile("s_waitcnt vmcnt(0)" ::: "memory");
    } else {
      XB_SPIN(xb_ld(&bar[XB_XGEN(xcc)]) == gen, bar);
      __builtin_amdgcn_fence(__ATOMIC_ACQUIRE, "agent");
      asm volatile("s_waitcnt vmcnt(0)" ::: "memory");
    }
  }
  __syncthreads();
}

__global__ void __launch_bounds__(256, 2) hybrid_fwd(Params P) {
  cg::grid_group grid = cg::this_grid();
  __shared__ __attribute__((aligned(16))) unsigned char smem[SMEM_BYTES];
#ifndef PHM
#define PHM 0x1ff
#endif
#ifndef DUP
#define DUP 0
#endif
  unsigned* bar = (unsigned*)(P.ws + OFF_CTR) + 1024;
  __shared__ __attribute__((aligned(16))) unsigned xb_words[4];
  if (threadIdx.x == 0) { xb_words[0] = 0u; xb_words[1] = 0u; }
  const unsigned xcc = xb_xcc_id();
  if (threadIdx.x == 0) (void)xb_add(&bar[XB_XCNT(xcc)], 1u);
  __syncthreads();
#define REPS(bit) (1 + ((DUP & (bit)) ? 1 : 0))
  phase_prep(P, smem, 0);
  if (P.out == nullptr) grid.sync();
  grid_barrier(bar, xcc, xb_words);
  for (int step = 0; step <= NGRP; ++step) {
    const bool merge_first = ((blockIdx.x >> 3) & 1) != 0;
#pragma unroll 1
    for (int part = 0; part < 2; ++part) {
      const bool do_merge = (part == 0) == merge_first;
      if (do_merge) { if (step >= 1) phase_merge(P, step - 1, smem); else phase_prep(P, smem, 1); }
      else { if (step < NGRP) phase_inproj(P, step, smem); }
    }
    grid_barrier(bar, xcc, xb_words);
    if (step < NGRP) {
      phase_mixers(P, step, 0, smem);
      grid_barrier(bar, xcc, xb_words);
      phase_combine(P);
      grid_barrier(bar, xcc, xb_words);
    }
  }
  for (int rep = 0; rep < REPS(16); ++rep) { phase_outproj(P, smem); if (rep + 1 < REPS(16)) grid_barrier(bar, xcc, xb_words); }
  grid_barrier(bar, xcc, xb_words);
  phase_ln1(P);
  grid_barrier(bar, xcc, xb_words);
  {
    const bool quant_first = ((blockIdx.x >> 3) & 1) != 0;
#pragma unroll 1
    for (int part = 0; part < 2; ++part) {
      if ((part == 0) == quant_first) {
        quantize_rows_fp8(P.peer_u, P.ws + OFF_UB, (float*)(P.ws + OFF_UB + (size_t)16384 * 1024));
        quantize_rows_fp4(P.peer_v, P.ws + OFF_VB, (float*)(P.ws + OFF_VB + (size_t)16384 * 1024));
      } else {
        phase_peerq(P, smem);
      }
    }
  }
  grid_barrier(bar, xcc, xb_words);
  for (int rep = 0; rep < REPS(128); ++rep) { phase_scores(P, smem); if (rep + 1 < REPS(128)) grid_barrier(bar, xcc, xb_words); }
  grid_barrier(bar, xcc, xb_words);
  for (int rep = 0; rep < REPS(256); ++rep) { phase_experts(P, smem); if (rep + 1 < REPS(256)) grid_barrier(bar, xcc, xb_words); }
}

extern "C" void kernel_launch(void* const* d_in, const int* in_sizes, int n_in, void* d_out, int out_size, void* d_ws,
                              size_t ws_size, hipStream_t stream) {
  static int grid_blocks = 0;
  if (grid_blocks == 0) {
    if (n_in != 24 || ws_size < WS_END) {
      fprintf(stderr, "kernel_launch: unexpected n_in %d or ws_size %zu (< %zu)\n", n_in, ws_size, (size_t)WS_END);
      grid_blocks = -1;
      return;
    }
    int dev = 0, cus = 0, per_cu = 0;
    (void)hipGetDevice(&dev);
    (void)hipDeviceGetAttribute(&cus, hipDeviceAttributeMultiprocessorCount, dev);
    (void)hipOccupancyMaxActiveBlocksPerMultiprocessor(&per_cu, (const void*)hybrid_fwd, 256, 0);
    if (per_cu < 1) { fprintf(stderr, "kernel_launch: occupancy query returned %d\n", per_cu); grid_blocks = -1; return; }
    if (per_cu > 2) per_cu = 2;
    grid_blocks = cus * per_cu;
  }
  if (grid_blocks < 0) return;
  (void)hipMemsetAsync((unsigned char*)d_ws + OFF_CTR, 0, 32768, stream);
  Params p{};
  const float** pp = (const float**)&p;
  for (int i = 0; i < 24; ++i) pp[i] = (const float*)d_in[i];
  p.out = (float*)d_out;
  p.ws = (unsigned char*)d_ws;
  void* args[] = {&p};
  hipError_t e = hipLaunchCooperativeKernel((const void*)hybrid_fwd, dim3(grid_blocks), dim3(256), args, 0, stream);
  if (e != hipSuccess) fprintf(stderr, "cooperative launch failed: %s (grid %d)\n", hipGetErrorString(e), grid_blocks);
}
```

```cpp
#include <hip/hip_runtime.h>
#include <hip/hip_cooperative_groups.h>
#include <stdint.h>
#include <stdio.h>
namespace cg = cooperative_groups;

typedef unsigned short u16;
typedef __attribute__((ext_vector_type(4))) unsigned u32x4;
typedef __attribute__((ext_vector_type(2))) unsigned u32x2;
typedef __attribute__((ext_vector_type(8))) short s16x8;
typedef __attribute__((ext_vector_type(16))) float f32x16;

constexpr int T_TOK = 32768;
constexpr int SEQ = 4096;
constexpr int DM = 1024;
constexpr int NGRP = 4;
constexpr int TG = T_TOK / NGRP;
constexpr int BPG = 2;
constexpr int D_IN = 10240;
constexpr float ALPHA = 1.189207115002721f;
constexpr float LN_EPS = 1e-5f;
constexpr float ATT_SCALE = 0.08838834764831845f;
constexpr float NEGBIG = -1e30f;

constexpr size_t OFF_WIN_T = 0;
constexpr size_t OFF_WBA_T = OFF_WIN_T + (size_t)10240 * 1024 * 2;
constexpr size_t OFF_WBL_T = OFF_WBA_T + (size_t)1024 * 512 * 2;
constexpr size_t OFF_WBM_T = OFF_WBL_T + (size_t)1024 * 1024 * 2;
constexpr size_t OFF_WOUT_T = OFF_WBM_T + (size_t)1024 * 512 * 2;
constexpr size_t OFF_WQ_T = OFF_WOUT_T + (size_t)1024 * 1024 * 2;
constexpr size_t OFF_KEYS = OFF_WQ_T + (size_t)2048 * 1024 * 2;
constexpr size_t OFF_WMKV_T = OFF_KEYS + (size_t)16 * 128 * 128 * 2;
constexpr size_t OFF_LWA_T = OFF_WMKV_T + (size_t)1024 * 1024 * 2;
constexpr size_t OFF_LWX_T = OFF_LWA_T + (size_t)16 * 64 * 64 * 2;
constexpr size_t OFF_MEMB = OFF_LWX_T + (size_t)16 * 64 * 64 * 2;
constexpr size_t OFF_MEMKV = OFF_MEMB + (size_t)2048 * 1024 * 2;
constexpr size_t OFF_UB = OFF_MEMKV + (size_t)2048 * 1024 * 2;
constexpr size_t OFF_VB = OFF_UB + (size_t)16384 * 1024 + 65536;
constexpr size_t OFF_CTR = OFF_VB + (size_t)16384 * 1024 + 65536;
constexpr size_t OFF_XB = OFF_CTR + 32768;
constexpr size_t OFF_MERGED = OFF_XB + (size_t)T_TOK * 1024 * 2;
constexpr size_t OFF_Z = OFF_MERGED + (size_t)T_TOK * 1024 * 2;
constexpr size_t OFF_ZQ = OFF_Z;
constexpr size_t OFF_ZK = OFF_ZQ + (size_t)TG * 1536 * 2;
constexpr size_t OFF_ZV = OFF_ZK + (size_t)TG * 1536 * 2;
constexpr size_t OFF_ZXR = OFF_ZV + (size_t)TG * 1536 * 2;
constexpr size_t OFF_ZYG = OFF_ZXR + (size_t)TG * 1024 * 2;
constexpr size_t OFF_ZMQ = OFF_ZYG + (size_t)TG * 1024 * 2;
constexpr size_t OFF_GATES = OFF_ZMQ + (size_t)TG * 512 * 2;
constexpr size_t OFF_GATES2 = OFF_GATES + (size_t)TG * 3072 * 2;
constexpr size_t OFF_OG = OFF_GATES2 + (size_t)TG * 3072 * 2;
constexpr size_t OFF_LSE = OFF_OG + (size_t)3 * TG * 512 * 2;
constexpr size_t OFF_MEMO = OFF_LSE + (size_t)3 * TG * 4 * 4;
constexpr size_t OFF_REC = OFF_MEMO + (size_t)TG * 512 * 2;
constexpr size_t OFF_ATTN = OFF_REC + (size_t)TG * 1024 * 2;
constexpr size_t OFF_HLOC = OFF_ATTN + (size_t)TG * 512 * 2;
constexpr size_t OFF_PCUM = OFF_HLOC + (size_t)TG * 1024 * 2;
constexpr size_t OFF_SUMA = OFF_PCUM + (size_t)TG * 1024 * 2;
constexpr size_t OFF_SUMH = OFF_SUMA + (size_t)BPG * 64 * 1024 * 4;
constexpr size_t OFF_ZEND = OFF_SUMH + (size_t)BPG * 64 * 1024 * 4;
constexpr size_t WS_END = OFF_ZEND;
constexpr size_t OFF_PQ = OFF_MERGED;
constexpr size_t OFF_Y = OFF_MERGED + (size_t)T_TOK * 2048 * 2;
constexpr size_t OFF_STOP = OFF_Y + (size_t)T_TOK * 1024 * 4;
constexpr size_t OFF_ITOP = OFF_STOP + (size_t)T_TOK * 256 * 4;
static_assert(OFF_ITOP + (size_t)T_TOK * 256 <= OFF_ZEND, "tail alias overflow");
static_assert(WS_END <= (size_t)512 * 1024 * 1024, "workspace too large");

constexpr int SMEM_BYTES = 73728;

struct Params {
  const float *x, *mem, *w_in, *b_gate, *conv_w, *conv_b, *lru_wa, *lru_ba, *lru_wx, *lru_bx, *lru_lambda,
      *w_mem_kv, *w_br_attn, *w_br_lru, *w_br_mem, *w_out, *ln1_g, *ln1_b, *peer_wq, *peer_keys, *peer_u, *peer_v,
      *ln2_g, *ln2_b;
  float* out;
  unsigned char* ws;
};

typedef __attribute__((ext_vector_type(2))) float f32x2_cv;
typedef __attribute__((ext_vector_type(2))) __bf16 bf16x2_cv;
__device__ __forceinline__ u16 f2bf(float f) { return __builtin_bit_cast(u16, (__bf16)f); }
__device__ __forceinline__ float bf2f(u16 h) { return __uint_as_float(((unsigned)h) << 16); }
__device__ __forceinline__ unsigned pack2(float a, float b) {
  f32x2_cv v = {a, b};
  return __builtin_bit_cast(unsigned, __builtin_convertvector(v, bf16x2_cv));
}
__device__ __forceinline__ float bflo(unsigned v) { return __uint_as_float(v << 16); }
__device__ __forceinline__ float bfhi(unsigned v) { return __uint_as_float(v & 0xffff0000u); }
__device__ __forceinline__ float sigmoidf_(float x) { return __builtin_amdgcn_rcpf(1.0f + __expf(-x)); }
__device__ __forceinline__ float gelu_tanh(float x) {
  float u = 0.7978845608028654f * (x + 0.044715f * x * x * x);
  return x * __builtin_amdgcn_rcpf(1.0f + __expf(-2.0f * u));
}
__device__ __forceinline__ float gelu_erf(float x) { return 0.5f * x * (1.0f + erff(x * 0.7071067811865476f)); }
template <int CTRL, int ROWMASK>
__device__ __forceinline__ float dpp_add0(float v) {
  return __builtin_bit_cast(float, __builtin_amdgcn_update_dpp(0, __builtin_bit_cast(int, v), CTRL, ROWMASK, 0xF, false));
}
template <int CTRL, int ROWMASK>
__device__ __forceinline__ float dpp_self(float v) {
  return __builtin_bit_cast(float, __builtin_amdgcn_update_dpp(__builtin_bit_cast(int, v), __builtin_bit_cast(int, v), CTRL, ROWMASK, 0xF, false));
}
__device__ __forceinline__ float wave_sum(float v) {
  v += dpp_add0<0xB1, 0xF>(v);
  v += dpp_add0<0x4E, 0xF>(v);
  v += dpp_add0<0x141, 0xF>(v);
  v += dpp_add0<0x140, 0xF>(v);
  v += dpp_add0<0x142, 0xA>(v);
  v += dpp_add0<0x143, 0xC>(v);
  return __builtin_bit_cast(float, __builtin_amdgcn_readlane(__builtin_bit_cast(int, v), 63));
}
__device__ __forceinline__ float half_sum(float v) {
  v += dpp_add0<0xB1, 0xF>(v);
  v += dpp_add0<0x4E, 0xF>(v);
  v += dpp_add0<0x141, 0xF>(v);
  v += dpp_add0<0x140, 0xF>(v);
  v += dpp_add0<0x142, 0xA>(v);
  const float lo = __builtin_bit_cast(float, __builtin_amdgcn_readlane(__builtin_bit_cast(int, v), 31));
  const float hi = __builtin_bit_cast(float, __builtin_amdgcn_readlane(__builtin_bit_cast(int, v), 63));
  return ((threadIdx.x & 32) != 0) ? hi : lo;
}
__device__ __forceinline__ float half_max(float v) {
  v = fmaxf(v, dpp_self<0xB1, 0xF>(v));
  v = fmaxf(v, dpp_self<0x4E, 0xF>(v));
  v = fmaxf(v, dpp_self<0x141, 0xF>(v));
  v = fmaxf(v, dpp_self<0x140, 0xF>(v));
  v = fmaxf(v, dpp_self<0x142, 0xA>(v));
  const float lo = __builtin_bit_cast(float, __builtin_amdgcn_readlane(__builtin_bit_cast(int, v), 31));
  const float hi = __builtin_bit_cast(float, __builtin_amdgcn_readlane(__builtin_bit_cast(int, v), 63));
  return ((threadIdx.x & 32) != 0) ? hi : lo;
}
__device__ __forceinline__ float wave_max_all(float v) {
  v = fmaxf(v, dpp_self<0xB1, 0xF>(v));
  v = fmaxf(v, dpp_self<0x4E, 0xF>(v));
  v = fmaxf(v, dpp_self<0x141, 0xF>(v));
  v = fmaxf(v, dpp_self<0x140, 0xF>(v));
  v = fmaxf(v, dpp_self<0x142, 0xA>(v));
  v = fmaxf(v, dpp_self<0x143, 0xC>(v));
  return __builtin_bit_cast(float, __builtin_amdgcn_readlane(__builtin_bit_cast(int, v), 63));
}
typedef __attribute__((ext_vector_type(2))) float f32x2;
__device__ __forceinline__ unsigned f2ord(float f) {
  unsigned b = __float_as_uint(f);
  return (b & 0x80000000u) ? ~b : (b | 0x80000000u);
}
__device__ __forceinline__ float ord2f(unsigned o) {
  return __uint_as_float((o & 0x80000000u) ? (o ^ 0x80000000u) : ~o);
}
#define TOPK_INSERT(L, x)                                   \
  {                                                         \
    unsigned x_ = (x);                                      \
    _Pragma("unroll") for (int j_ = 0; j_ < 16; ++j_) {     \
      unsigned t_ = max(L[j_], x_);                         \
      x_ = min(L[j_], x_);                                  \
      L[j_] = t_;                                           \
    }                                                       \
  }
__device__ __forceinline__ int otid() {
  int t;
  asm volatile("v_mov_b32 %0, %1" : "=v"(t) : "v"(threadIdx.x));
  return t;
}
__device__ __forceinline__ f32x16 mfma32(s16x8 a, s16x8 b, f32x16 c) {
  return __builtin_amdgcn_mfma_f32_32x32x16_bf16(a, b, c, 0, 0, 0);
}
__device__ __forceinline__ f32x16 zero16() {
  f32x16 z;
#pragma unroll
  for (int i = 0; i < 16; ++i) z[i] = 0.f;
  return z;
}

template <int DEPTH, class LA>
__device__ __forceinline__ void gemm_mainloop_t(f32x16 (&acc)[2][2], LA la, const u16* __restrict__ Bt, unsigned ldb,
                                                int K, u16* smem) {
  const int tid = otid(), lane = tid & 63, w = tid >> 6, wm = w & 1, wn = w >> 1;
  const unsigned boff = (unsigned)(tid >> 3) * ldb + (tid & 7) * 8;
  const unsigned soff = (unsigned)(tid >> 3) * 72 + (tid & 7) * 8;
  la.init(tid);
  u32x4 ra0[4], rb0[4], ra1[4], rb1[4];
#pragma unroll
  for (int i = 0; i < 4; ++i) {
    ra0[i] = la.load(i, 0);
    rb0[i] = *(const u32x4*)(Bt + (size_t)(32 * i) * ldb + boff);
  }
  if (DEPTH == 2) {
    const int k1 = (64 < K) ? 64 : 0;
#pragma unroll
    for (int i = 0; i < 4; ++i) {
      ra1[i] = la.load(i, k1);
      rb1[i] = *(const u32x4*)(Bt + (size_t)(32 * i) * ldb + k1 + boff);
    }
  }
  __syncthreads();
  int buf = 0;
  for (int k0 = 0; k0 < K; k0 += 64 * DEPTH) {
#pragma unroll
    for (int ph = 0; ph < DEPTH; ++ph) {
      u16* sA = smem + buf * (2 * 128 * 72);
      u16* sB = sA + 128 * 72;
#pragma unroll
      for (int i = 0; i < 4; ++i) {
        *(u32x4*)(sA + i * 32 * 72 + soff) = (ph == 0) ? ra0[i] : ra1[i];
        *(u32x4*)(sB + i * 32 * 72 + soff) = (ph == 0) ? rb0[i] : rb1[i];
      }
      __syncthreads();
      {
        int kn = k0 + 64 * ph + 64 * DEPTH;
        kn = (kn < K) ? kn : 0;
#pragma unroll
        for (int i = 0; i < 4; ++i) {
          if (ph == 0) {
            ra0[i] = la.load(i, kn);
            rb0[i] = *(const u32x4*)(Bt + (size_t)(32 * i) * ldb + kn + boff);
          } else {
            ra1[i] = la.load(i, kn);
            rb1[i] = *(const u32x4*)(Bt + (size_t)(32 * i) * ldb + kn + boff);
          }
        }
      }
      const u16* pa = sA + (wm * 64 + (lane & 31)) * 72 + (lane >> 5) * 8;
      const u16* pb = sB + (wn * 64 + (lane & 31)) * 72 + (lane >> 5) * 8;
#pragma unroll
      for (int ks = 0; ks < 4; ++ks) {
        s16x8 a0 = *(const s16x8*)(pa + ks * 16);
        s16x8 a1 = *(const s16x8*)(pa + 32 * 72 + ks * 16);
        s16x8 b0 = *(const s16x8*)(pb + ks * 16);
        s16x8 b1 = *(const s16x8*)(pb + 32 * 72 + ks * 16);
        acc[0][0] = mfma32(a0, b0, acc[0][0]);
        acc[0][1] = mfma32(a0, b1, acc[0][1]);
        acc[1][0] = mfma32(a1, b0, acc[1][0]);
        acc[1][1] = mfma32(a1, b1, acc[1][1]);
      }
      buf ^= 1;
    }
  }
}
template <class LA>
__device__ __forceinline__ void gemm_mainloop(f32x16 (&acc)[2][2], LA la, const u16* __restrict__ Bt, unsigned ldb, int K,
                                              u16* smem) {
  gemm_mainloop_t<2, LA>(acc, la, Bt, ldb, K, smem);
}

template <class LA>
__device__ __forceinline__ void gemm_mainloop_wide(f32x16 (&acc)[2][4], LA la, const u16* __restrict__ Bt, unsigned ldb,
                                                   int K, u16* smem) {
  u16* sA = smem;
  u16* sB = smem + 128 * 72;
  const int tid = otid(), lane = tid & 63, w = tid >> 6, wm = w & 1, wn = w >> 1;
  const unsigned boff = (unsigned)(tid >> 3) * ldb + (tid & 7) * 8;
  const unsigned soff = (unsigned)(tid >> 3) * 72 + (tid & 7) * 8;
  la.init(tid);
  u32x4 ra[4], rb[8];
#pragma unroll
  for (int i = 0; i < 4; ++i) ra[i] = la.load(i, 0);
#pragma unroll
  for (int i = 0; i < 8; ++i) rb[i] = *(const u32x4*)(Bt + (size_t)(32 * i) * ldb + boff);
  for (int k0 = 0; k0 < K; k0 += 64) {
    __syncthreads();
#pragma unroll
    for (int i = 0; i < 4; ++i) *(u32x4*)(sA + i * 32 * 72 + soff) = ra[i];
#pragma unroll
    for (int i = 0; i < 8; ++i) *(u32x4*)(sB + i * 32 * 72 + soff) = rb[i];
    __syncthreads();
    {
      const int kn = (k0 + 64 < K) ? (k0 + 64) : 0;
#pragma unroll
      for (int i = 0; i < 4; ++i) ra[i] = la.load(i, kn);
#pragma unroll
      for (int i = 0; i < 8; ++i) rb[i] = *(const u32x4*)(Bt + (size_t)(32 * i) * ldb + kn + boff);
    }
    const u16* pa = sA + (wm * 64 + (lane & 31)) * 72 + (lane >> 5) * 8;
    const u16* pb = sB + (wn * 32 + (lane & 31)) * 72 + (lane >> 5) * 8;
#pragma unroll
    for (int ks = 0; ks < 4; ++ks) {
      s16x8 a0 = *(const s16x8*)(pa + ks * 16);
      s16x8 a1 = *(const s16x8*)(pa + 32 * 72 + ks * 16);
#pragma unroll
      for (int ni = 0; ni < 4; ++ni) {
        s16x8 b = *(const s16x8*)(pb + ni * 64 * 72 + ks * 16);
        acc[0][ni] = mfma32(a0, b, acc[0][ni]);
        acc[1][ni] = mfma32(a1, b, acc[1][ni]);
      }
    }
  }
}
template <int H2>
__device__ __forceinline__ void acc_to_lds_wide(f32x16 (&acc)[2][4], float* sC) {
  const int lane = otid() & 63, w = otid() >> 6, wm = w & 1, wn = w >> 1;
  __syncthreads();
  float* p = sC + (wm * 64 + (lane >> 5) * 4) * 132 + wn * 32 + (lane & 31);
#pragma unroll
  for (int mi = 0; mi < 2; ++mi)
#pragma unroll
    for (int j = 0; j < 2; ++j)
#pragma unroll
      for (int i = 0; i < 16; ++i) p[(mi * 32 + (i >> 2) * 8 + (i & 3)) * 132 + j * 64] = acc[mi][2 * H2 + j][i];
  __syncthreads();
}

struct LoadBf16 {
  const u16* A;
  unsigned lda;
  unsigned off;
  __device__ __forceinline__ void init(int tid) { off = (unsigned)(tid >> 3) * lda + (tid & 7) * 8; }
  __device__ __forceinline__ u32x4 load(int i, int k0) const {
    return *(const u32x4*)(A + (size_t)(32 * i) * lda + k0 + off);
  }
};

__device__ __forceinline__ void acc_to_lds(f32x16 (&acc)[2][2], float* sC) {
  const int lane = otid() & 63, w = otid() >> 6, wm = w & 1, wn = w >> 1;
  __syncthreads();
  float* p = sC + (wm * 64 + (lane >> 5) * 4) * 132 + wn * 64 + (lane & 31);
#pragma unroll
  for (int mi = 0; mi < 2; ++mi)
#pragma unroll
    for (int ni = 0; ni < 2; ++ni)
#pragma unroll
      for (int i = 0; i < 16; ++i) p[(mi * 32 + (i >> 2) * 8 + (i & 3)) * 132 + ni * 32] = acc[mi][ni][i];
  __syncthreads();
}
typedef __attribute__((ext_vector_type(4))) float f32x4;
__device__ __forceinline__ u32x4 pack8(f32x4 a, f32x4 b) {
  u32x4 o;
  o.x = pack2(a.x, a.y); o.y = pack2(a.z, a.w); o.z = pack2(b.x, b.y); o.w = pack2(b.z, b.w);
  return o;
}
__device__ __forceinline__ void acc_zero(f32x16 (&acc)[2][2]) {
#pragma unroll
  for (int mi = 0; mi < 2; ++mi)
#pragma unroll
    for (int ni = 0; ni < 2; ++ni) acc[mi][ni] = zero16();
}

__device__ void convert_span(const float* __restrict__ src, u16* __restrict__ dst, size_t n) {
  size_t gt = (size_t)blockIdx.x * 256 + otid(), gs = (size_t)gridDim.x * 256;
  for (size_t i = gt * 8; i < n; i += gs * 8) {
    float4 a = *(const float4*)(src + i), b = *(const float4*)(src + i + 4);
    u32x4 o;
    o.x = pack2(a.x, a.y); o.y = pack2(a.z, a.w); o.z = pack2(b.x, b.y); o.w = pack2(b.z, b.w);
    *(u32x4*)(dst + i) = o;
  }
}
__device__ void transpose_tile(const float* __restrict__ src, int R, int C, u16* __restrict__ dst, int tr, int tc,
                               float* sm) {
  const int tid = otid();
  __syncthreads();
#pragma unroll
  for (int i = 0; i < 4; ++i) {
    int r = (tid >> 4) + 16 * i, c4 = (tid & 15) * 4;
    float4 v = *(const float4*)(src + (size_t)(tr * 64 + r) * C + tc * 64 + c4);
    sm[r * 65 + c4 + 0] = v.x; sm[r * 65 + c4 + 1] = v.y; sm[r * 65 + c4 + 2] = v.z; sm[r * 65 + c4 + 3] = v.w;
  }
  __syncthreads();
#pragma unroll
  for (int i = 0; i < 2; ++i) {
    int c = (tid >> 3) + 32 * i, r8 = (tid & 7) * 8;
    float e[8];
#pragma unroll
    for (int j = 0; j < 8; ++j) e[j] = sm[(r8 + j) * 65 + c];
    u32x4 o;
    o.x = pack2(e[0], e[1]); o.y = pack2(e[2], e[3]); o.z = pack2(e[4], e[5]); o.w = pack2(e[6], e[7]);
    *(u32x4*)(dst + (size_t)(tc * 64 + c) * R + tr * 64 + r8) = o;
  }
}

__device__ void quantize_rows_fp8(const float* __restrict__ src, unsigned char* __restrict__ dst, float* __restrict__ inv_scale) {
  const int lane = otid() & 63;
  const int gw = blockIdx.x * 4 + (otid() >> 6), nw = gridDim.x * 4;
  for (int row = gw; row < 16384; row += nw) {
    const float* p = src + (size_t)row * 1024 + lane * 16;
    f32x4 v[4];
    float am = 0.f;
#pragma unroll
    for (int q = 0; q < 4; ++q) {
      v[q] = *(const f32x4*)(p + 4 * q);
      am = fmaxf(am, fmaxf(fmaxf(fabsf(v[q].x), fabsf(v[q].y)), fmaxf(fabsf(v[q].z), fabsf(v[q].w))));
    }
    am = wave_max_all(am);
    const float sc = (am > 0.f) ? 224.0f / am : 1.0f;
    u32x4 o;
#pragma unroll
    for (int q = 0; q < 4; ++q) {
      int wv = __builtin_amdgcn_cvt_pk_fp8_f32(v[q].x * sc, v[q].y * sc, 0, false);
      wv = __builtin_amdgcn_cvt_pk_fp8_f32(v[q].z * sc, v[q].w * sc, wv, true);
      o[q] = (unsigned)wv;
    }
    *(u32x4*)(dst + (size_t)row * 1024 + lane * 16) = o;
    if (lane == 0) inv_scale[row] = (am > 0.f) ? am * (1.0f / 224.0f) : 1.0f;
  }
}

__device__ void quantize_rows_fp4(const float* __restrict__ src, unsigned char* __restrict__ dst, float* __restrict__ inv_scale) {
  const int lane = otid() & 63;
  const int gw = blockIdx.x * 4 + (otid() >> 6), nw = gridDim.x * 4;
  for (int row = gw; row < 16384; row += nw) {
    const float* p = src + (size_t)row * 1024 + lane * 16;
    f32x4 v[4];
    float am = 0.f;
#pragma unroll
    for (int q = 0; q < 4; ++q) {
      v[q] = *(const f32x4*)(p + 4 * q);
      am = fmaxf(am, fmaxf(fmaxf(fabsf(v[q].x), fabsf(v[q].y)), fmaxf(fabsf(v[q].z), fabsf(v[q].w))));
    }
    am = wave_max_all(am);
    const float sc = (am > 0.f) ? 6.0f / am : 1.0f;
    u32x2 o;
#pragma unroll
    for (int wd = 0; wd < 2; ++wd) {
      unsigned wv = 0u;
      wv = __builtin_amdgcn_cvt_scalef32_pk_fp4_f32(wv, v[2 * wd].x * sc, v[2 * wd].y * sc, 1.0f, 0);
      wv = __builtin_amdgcn_cvt_scalef32_pk_fp4_f32(wv, v[2 * wd].z * sc, v[2 * wd].w * sc, 1.0f, 1);
      wv = __builtin_amdgcn_cvt_scalef32_pk_fp4_f32(wv, v[2 * wd + 1].x * sc, v[2 * wd + 1].y * sc, 1.0f, 2);
      wv = __builtin_amdgcn_cvt_scalef32_pk_fp4_f32(wv, v[2 * wd + 1].z * sc, v[2 * wd + 1].w * sc, 1.0f, 3);
      o[wd] = wv;
    }
    *(u32x2*)(dst + (size_t)row * 512 + lane * 8) = o;
    if (lane == 0) inv_scale[row] = (am > 0.f) ? am * (1.0f / 6.0f) : 1.0f;
  }
}

__device__ void phase_prep(const Params& P, unsigned char* smem, int part) {
  unsigned char* ws = P.ws;
  if (part == 0) {
    convert_span(P.x, (u16*)(ws + OFF_XB), (size_t)TG * 1024);
    convert_span(P.mem, (u16*)(ws + OFF_MEMB), (size_t)2048 * 1024);
  } else {
    convert_span(P.x + (size_t)TG * 1024, (u16*)(ws + OFF_XB) + (size_t)TG * 1024, (size_t)(T_TOK - TG) * 1024);
    convert_span(P.peer_keys, (u16*)(ws + OFF_KEYS), (size_t)16 * 128 * 128);
  }
  constexpr int N0 = 16 * 160, N1 = 8 * 16, N2 = 16 * 16, N3 = 8 * 16, N4 = 16 * 16, N5 = 16 * 32, N6 = 16 * 16, N7 = 16, N8 = 16;
  constexpr int NT = N0 + N1 + N2 + N3 + N4 + N5 + N6 + N7 + N8;
  float* sm = (float*)smem;
  for (int t = blockIdx.x; t < NT; t += gridDim.x) {
    int u = t;
    const bool early = (t < N0) || (t >= N0 + N1 + N2 + N3 + N4 + N5);
    if (early != (part == 0)) continue;
    if (u < N0) { transpose_tile(P.w_in, 1024, D_IN, (u16*)(ws + OFF_WIN_T), u / 160, u % 160, sm); continue; }
    u -= N0;
    if (u < N1) { transpose_tile(P.w_br_attn, 512, 1024, (u16*)(ws + OFF_WBA_T), u / 16, u % 16, sm); continue; }
    u -= N1;
    if (u < N2) { transpose_tile(P.w_br_lru, 1024, 1024, (u16*)(ws + OFF_WBL_T), u / 16, u % 16, sm); continue; }
    u -= N2;
    if (u < N3) { transpose_tile(P.w_br_mem, 512, 1024, (u16*)(ws + OFF_WBM_T), u / 16, u % 16, sm); continue; }
    u -= N3;
    if (u < N4) { transpose_tile(P.w_out, 1024, 1024, (u16*)(ws + OFF_WOUT_T), u / 16, u % 16, sm); continue; }
    u -= N4;
    if (u < N5) { transpose_tile(P.peer_wq, 1024, 2048, (u16*)(ws + OFF_WQ_T), u / 32, u % 32, sm); continue; }
    u -= N5;
    if (u < N6) { transpose_tile(P.w_mem_kv, 1024, 1024, (u16*)(ws + OFF_WMKV_T), u / 16, u % 16, sm); continue; }
    u -= N6;
    if (u < N7) { transpose_tile(P.lru_wa + (size_t)u * 4096, 64, 64, (u16*)(ws + OFF_LWA_T) + (size_t)u * 4096, 0, 0, sm); continue; }
    u -= N7;
    transpose_tile(P.lru_wx + (size_t)u * 4096, 64, 64, (u16*)(ws + OFF_LWX_T) + (size_t)u * 4096, 0, 0, sm);
  }
}

template <int H2>
__device__ __forceinline__ void inproj_store_half(const Params& P, f32x16 (&acc)[2][4], unsigned char* smem, u16* dst, int ld,
                                                  int c0, int rt, bool is_gate) {
  acc_to_lds_wide<H2>(acc, (float*)smem);
  const float* sC = (const float*)smem;
  const int cb = c0 + H2 * 128;
  if (!is_gate) {
#pragma unroll 2
    for (int it = 0; it < 8; ++it) {
      const int idx = otid() + 256 * it, row = idx >> 4, c8 = (idx & 15) * 8;
      f32x4 v0 = *(const f32x4*)(sC + row * 132 + c8), v1 = *(const f32x4*)(sC + row * 132 + c8 + 4);
      __builtin_nontemporal_store(pack8(v0, v1), (u32x4*)(dst + (size_t)(rt * 128 + row) * ld + cb + c8));
    }
  } else {
    const float* bg = P.b_gate + cb;
#pragma unroll 2
    for (int it = 0; it < 8; ++it) {
      const int idx = otid() + 256 * it, row = idx >> 4, c8 = (idx & 15) * 8;
      f32x4 v0 = *(const f32x4*)(sC + row * 132 + c8), v1 = *(const f32x4*)(sC + row * 132 + c8 + 4);
      f32x4 b0 = *(const f32x4*)(bg + c8), b1 = *(const f32x4*)(bg + c8 + 4);
#pragma unroll
      for (int j = 0; j < 4; ++j) { v0[j] = sigmoidf_(v0[j] + b0[j]); v1[j] = sigmoidf_(v1[j] + b1[j]); }
      __builtin_nontemporal_store(pack8(v0, v1), (u32x4*)(dst + (size_t)(rt * 128 + row) * ld + cb + c8));
    }
  }
}

__device__ void phase_inproj(const Params& P, int g, unsigned char* smem) {
  unsigned char* ws = P.ws;
  const u16* xb = (const u16*)(ws + OFF_XB) + (size_t)g * TG * 1024;
  const u16* wt = (const u16*)(ws + OFF_WIN_T);
  constexpr int NRT = TG / 128;
  constexpr int NCT = D_IN / 256;
  for (int t = blockIdx.x; t < NRT * NCT; t += gridDim.x) {
    const int ct = t / NRT, rt = t % NRT;
    f32x16 acc[2][4];
#pragma unroll
    for (int mi = 0; mi < 2; ++mi)
#pragma unroll
      for (int ni = 0; ni < 4; ++ni) acc[mi][ni] = zero16();
    LoadBf16 la{xb + (size_t)rt * 128 * 1024, 1024, 0};
    gemm_mainloop_wide(acc, la, wt + (size_t)ct * 256 * 1024, 1024, 1024, (u16*)smem);
    const int n0 = ct * 256;
    u16* dst; int ld, c0;
    if (n0 < 1536) { dst = (u16*)(ws + OFF_ZQ); ld = 1536; c0 = n0; }
    else if (n0 < 3072) { dst = (u16*)(ws + OFF_ZK); ld = 1536; c0 = n0 - 1536; }
    else if (n0 < 4608) { dst = (u16*)(ws + OFF_ZV); ld = 1536; c0 = n0 - 3072; }
    else if (n0 < 5632) { dst = (u16*)(ws + OFF_ZXR); ld = 1024; c0 = n0 - 4608; }
    else if (n0 < 6656) { dst = (u16*)(ws + OFF_ZYG); ld = 1024; c0 = n0 - 5632; }
    else if (n0 < 7168) { dst = (u16*)(ws + OFF_ZMQ); ld = 512; c0 = n0 - 6656; }
    else { dst = (u16*)(ws + ((g & 1) ? OFF_GATES2 : OFF_GATES)); ld = 3072; c0 = n0 - 7168; }
    const bool is_gate = (n0 >= 7168);
    inproj_store_half<0>(P, acc, smem, dst, ld, c0, rt, is_gate);
    inproj_store_half<1>(P, acc, smem, dst, ld, c0, rt, is_gate);
  }
  if (g == 0) {
    for (int u = blockIdx.x; u < 16 * 8; u += gridDim.x) {
      const int ct = u / 16, rt = u % 16;
      f32x16 acc[2][2];
      acc_zero(acc);
      LoadBf16 la{(const u16*)(ws + OFF_MEMB) + (size_t)rt * 128 * 1024, 1024, 0};
      gemm_mainloop(acc, la, (const u16*)(ws + OFF_WMKV_T) + (size_t)ct * 128 * 1024, 1024, 1024, (u16*)smem);
      u16* dst = (u16*)(ws + OFF_MEMKV);
      acc_to_lds(acc, (float*)smem);
      const float* sC = (const float*)smem;
#pragma unroll 2
      for (int it = 0; it < 8; ++it) {
        const int idx = otid() + 256 * it, row = idx >> 4, c8 = (idx & 15) * 8;
        f32x4 v0 = *(const f32x4*)(sC + row * 132 + c8), v1 = *(const f32x4*)(sC + row * 132 + c8 + 4);
        *(u32x4*)(dst + (size_t)(rt * 128 + row) * 1024 + ct * 128 + c8) = pack8(v0, v1);
      }
    }
  }
}

__device__ __forceinline__ void attn_block(const u16* __restrict__ Q, size_t qs, const u16* __restrict__ K0,
                                           const u16* __restrict__ V0, int mode0, const u16* __restrict__ K1,
                                           const u16* __restrict__ V1, int mode1, size_t kvs, u16* __restrict__ O, size_t os,
                                           float* __restrict__ lse, size_t lses, u16* smem) {
  typedef __attribute__((ext_vector_type(4))) short s16x4;
  typedef __attribute__((address_space(3))) s16x4 lds_s16x4;
  u16* sK = smem;
  u16* sV = smem + 64 * 136;
  const int tid = otid(), lane = tid & 63, w = tid >> 6, hh = lane >> 5;
  size_t qoff = (size_t)(w * 32 + (lane & 31)) * qs + hh * 8;
  f32x16 o[4];
#pragma unroll
  for (int dt = 0; dt < 4; ++dt) o[dt] = zero16();
  float m_run = NEGBIG, l_run = 0.f;
  const int trq = (lane & 15) >> 2, trp = lane & 3, trg = lane >> 4;
  const u16* trbase = sV + ((trg >> 1) * 4 + trq) * 160 + (trg & 1) * 16 + trp * 4;
  constexpr float C2 = ATT_SCALE * 1.4426950408889634f;
  const int qrow = w * 32 + (lane & 31);

  u32x4 pk[4], pv[4];
#pragma unroll
  for (int i = 0; i < 4; ++i) {
    int id = tid + 256 * i, row = id >> 4, c = id & 15;
    pk[i] = *(const u32x4*)(K0 + (size_t)row * kvs + c * 8);
    pv[i] = *(const u32x4*)(V0 + (size_t)row * kvs + c * 8);
  }
  s16x8 qf[8];
#pragma unroll
  for (int ks = 0; ks < 8; ++ks) qf[ks] = *(const s16x8*)(Q + qoff + ks * 16);
#pragma unroll 1
  for (int sb = 0; sb < 4; ++sb) {
    const int hf = sb >> 1;
    const int mode = hf ? mode1 : mode0;
    if (mode < 0) continue;
    const int kbase = (sb & 1) * 64;
    const bool active = (mode == 0) || (mode == 1 ? (kbase <= w * 32 + 31) : (kbase + 63 >= w * 32));
    const bool need_mask = (mode != 0) && (mode == 1 ? (kbase + 63 > w * 32) : (kbase < w * 32 + 31));
    __syncthreads();
#pragma unroll
    for (int i = 0; i < 4; ++i) {
      int id = tid + 256 * i, row = id >> 4, c = id & 15;
      *(u32x4*)(sK + row * 136 + c * 8) = pk[i];
      *(u32x4*)(sV + row * 160 + c * 8) = pv[i];
    }
    __syncthreads();
    {
      const int nsb = sb + 1;
      const int nmode = (nsb >> 1) ? mode1 : mode0;
      if (nsb < 4 && nmode >= 0) {
        const u16* Kn = ((nsb >> 1) ? K1 : K0) + (size_t)((nsb & 1) * 64) * kvs;
        const u16* Vn = ((nsb >> 1) ? V1 : V0) + (size_t)((nsb & 1) * 64) * kvs;
#pragma unroll
        for (int i = 0; i < 4; ++i) {
          int id = tid + 256 * i, row = id >> 4, c = id & 15;
          pk[i] = *(const u32x4*)(Kn + (size_t)row * kvs + c * 8);
          pv[i] = *(const u32x4*)(Vn + (size_t)row * kvs + c * 8);
        }
      }
    }
    if (active) {
      f32x16 s[2];
      s[0] = zero16(); s[1] = zero16();
#pragma unroll
      for (int ks = 0; ks < 8; ++ks) {
#pragma unroll
        for (int nt = 0; nt < 2; ++nt) {
          s16x8 kfr = *(const s16x8*)(sK + (nt * 32 + (lane & 31)) * 136 + ks * 16 + hh * 8);
          s[nt] = mfma32(kfr, qf[ks], s[nt]);
        }
      }
      float mx = NEGBIG;
      if (need_mask) {
#pragma unroll
        for (int nt = 0; nt < 2; ++nt)
#pragma unroll
          for (int i = 0; i < 16; ++i) {
            const int key = kbase + nt * 32 + (i >> 2) * 8 + hh * 4 + (i & 3);
            const bool ok = (mode == 1) ? (key <= qrow) : (key >= qrow);
            s[nt][i] = ok ? s[nt][i] : NEGBIG;
          }
      }
#pragma unroll
      for (int nt = 0; nt < 2; ++nt)
#pragma unroll
        for (int i = 0; i < 16; ++i) mx = fmaxf(mx, s[nt][i]);
      mx = fmaxf(mx, __shfl_xor(mx, 32, 64));
      const float m_new = fmaxf(m_run, mx);
      const float alpha = __builtin_amdgcn_exp2f((m_run - m_new) * C2);
      m_run = m_new;
      const float mc = -m_new * C2;
      float ps = 0.f;
#pragma unroll
      for (int nt = 0; nt < 2; ++nt)
#pragma unroll
        for (int i = 0; i < 16; ++i) {
          const float p = __builtin_amdgcn_exp2f(fmaf(s[nt][i], C2, mc));
          s[nt][i] = p;
          ps += p;
        }
      l_run = l_run * alpha + ps;
#pragma unroll
      for (int dt = 0; dt < 4; ++dt)
#pragma unroll
        for (int i = 0; i < 16; ++i) o[dt][i] *= alpha;
#pragma unroll
      for (int nt = 0; nt < 2; ++nt)
#pragma unroll
        for (int s2 = 0; s2 < 2; ++s2) {
          u32x4 pb;
          pb.x = pack2(s[nt][8 * s2 + 0], s[nt][8 * s2 + 1]);
          pb.y = pack2(s[nt][8 * s2 + 2], s[nt][8 * s2 + 3]);
          pb.z = pack2(s[nt][8 * s2 + 4], s[nt][8 * s2 + 5]);
          pb.w = pack2(s[nt][8 * s2 + 6], s[nt][8 * s2 + 7]);
          const s16x8 pfr = __builtin_bit_cast(s16x8, pb);
#pragma unroll
          for (int dt = 0; dt < 4; ++dt) {
            const u16* ptr = trbase + (nt * 32 + s2 * 16) * 160 + dt * 32;
            s16x4 r1 = __builtin_amdgcn_ds_read_tr16_b64_v4i16((lds_s16x4*)ptr);
            s16x4 r2 = __builtin_amdgcn_ds_read_tr16_b64_v4i16((lds_s16x4*)(ptr + 8 * 160));
            s16x8 vfr = {r1[0], r1[1], r1[2], r1[3], r2[0], r2[1], r2[2], r2[3]};
            o[dt] = mfma32(vfr, pfr, o[dt]);
          }
        }
    }
  }
  const float l_tot = l_run + __shfl_xor(l_run, 32, 64);
  const float inv = 1.0f / l_tot;
  __syncthreads();
  u16* sO = smem + w * 32 * 136;
#pragma unroll
  for (int dt = 0; dt < 4; ++dt)
#pragma unroll
    for (int g4 = 0; g4 < 4; ++g4) {
      u32x2 pr;
      pr.x = pack2(o[dt][4 * g4 + 0] * inv, o[dt][4 * g4 + 1] * inv);
      pr.y = pack2(o[dt][4 * g4 + 2] * inv, o[dt][4 * g4 + 3] * inv);
      *(u32x2*)(sO + (lane & 31) * 136 + dt * 32 + g4 * 8 + hh * 4) = pr;
    }
  if (lse != nullptr && lane < 32) lse[(size_t)(w * 32 + lane) * lses] = m_run * ATT_SCALE + __logf(l_tot);
  __syncthreads();
#pragma unroll 2
  for (int it = 0; it < 8; ++it) {
    const int ch = lane + 64 * it, r = ch >> 4, c = ch & 15;
    *(u32x4*)(O + (size_t)(w * 32 + r) * os + c * 8) = *(const u32x4*)(sO + r * 136 + c * 8);
  }
}

__device__ __forceinline__ void lru_chunk_item(const Params& P, int b_local, int nb, int grp4, unsigned char* smem) {
  unsigned char* ws = P.ws;
  const int tid = otid(), lane = tid & 63, w = tid >> 6, tm = w & 1, tn = w >> 1;
  const int c0 = nb * 64;
  float* sXr = (float*)smem;
  float* sAa = sXr;
  float* sXc = sXr + 67 * 65;
  float* sBb = sXc + 64 * 65;
  float* sSegA = sBb + 64 * 65;
  float* sSegH = sSegA + 256;
  u16* sA = (u16*)(sSegH + 256);
  float* sHg = (float*)(sA + 64 * 72);
  float* sPg = sHg + 64;
  const size_t tokb = (size_t)b_local * SEQ;
  const u16* zxr = (const u16*)(ws + OFF_ZXR) + tokb * 1024 + c0;
  u16* hloc = (u16*)(ws + OFF_HLOC) + tokb * 1024 + c0;
  u16* pcum = (u16*)(ws + OFF_PCUM) + tokb * 1024 + c0;
  s16x8 fa[4], fx[4];
  {
    const u16* wa = (const u16*)(ws + OFF_LWA_T) + (size_t)nb * 4096 + (tn * 32 + (lane & 31)) * 64 + (lane >> 5) * 8;
    const u16* wx = (const u16*)(ws + OFF_LWX_T) + (size_t)nb * 4096 + (tn * 32 + (lane & 31)) * 64 + (lane >> 5) * 8;
#pragma unroll
    for (int ks = 0; ks < 4; ++ks) { fa[ks] = *(const s16x8*)(wa + ks * 16); fx[ks] = *(const s16x8*)(wx + ks * 16); }
  }
  const int jch = tn * 32 + (lane & 31);
  const float ba_j = P.lru_ba[c0 + jch], bx_j = P.lru_bx[c0 + jch];
  float sp_j;
  {
    float nl = -P.lru_lambda[c0 + jch];
    sp_j = fmaxf(nl, 0.f) + log1pf(__expf(-fabsf(nl)));
  }
  const int cch = tid & 63, seg = tid >> 6;
  const float cw0 = P.conv_w[0 * 1024 + c0 + cch], cw1 = P.conv_w[1 * 1024 + c0 + cch], cw2 = P.conv_w[2 * 1024 + c0 + cch],
              cw3 = P.conv_w[3 * 1024 + c0 + cch], cbb = P.conv_b[c0 + cch];
  __syncthreads();
  if (tid < 64) { sHg[tid] = 0.f; sPg[tid] = 1.f; }
  float hlast = 0.f, plast = 1.f;
  u32x4 pf[3];
#pragma unroll
  for (int i = 0; i < 3; ++i) {
    const int id = tid + 256 * i, r = id >> 3, c8 = (id & 7) * 8, t = grp4 * 256 - 3 + r;
    pf[i] = u32x4{0u, 0u, 0u, 0u};
    if (id < 67 * 8 && t >= 0) pf[i] = *(const u32x4*)(zxr + (size_t)t * 1024 + c8);
  }
#pragma unroll 1
  for (int ck = grp4 * 4; ck < grp4 * 4 + 4; ++ck) {
  const int t0 = ck * 64;
  __syncthreads();
#pragma unroll
  for (int i = 0; i < 3; ++i) {
    const int id = tid + 256 * i, r = id >> 3, c8 = (id & 7) * 8;
    if (id < 67 * 8) {
#pragma unroll
      for (int j = 0; j < 4; ++j) { sXr[r * 65 + c8 + 2 * j] = bflo(pf[i][j]); sXr[r * 65 + c8 + 2 * j + 1] = bfhi(pf[i][j]); }
    }
  }
  if (ck + 1 < grp4 * 4 + 4) {
#pragma unroll
    for (int i = 0; i < 3; ++i) {
      const int id = tid + 256 * i, r = id >> 3, c8 = (id & 7) * 8, t = t0 + 64 - 3 + r;
      if (id < 67 * 8) pf[i] = *(const u32x4*)(zxr + (size_t)t * 1024 + c8);
    }
  }
  __syncthreads();
#pragma unroll
  for (int e = 0; e < 16; ++e) {
    int t = seg * 16 + e;
    float xc = cbb + cw0 * sXr[t * 65 + cch] + cw1 * sXr[(t + 1) * 65 + cch] + cw2 * sXr[(t + 2) * 65 + cch] +
               cw3 * sXr[(t + 3) * 65 + cch];
    sXc[t * 65 + cch] = xc;
    sA[t * 72 + cch] = f2bf(xc);
  }
  __syncthreads();
  f32x16 racc = zero16(), iacc = zero16();
#pragma unroll
  for (int ks = 0; ks < 4; ++ks) {
    s16x8 a = *(const s16x8*)(sA + (tm * 32 + (lane & 31)) * 72 + ks * 16 + (lane >> 5) * 8);
    racc = mfma32(a, fa[ks], racc);
    iacc = mfma32(a, fx[ks], iacc);
  }
#pragma unroll
  for (int i = 0; i < 16; ++i) {
    int t = tm * 32 + (i >> 2) * 8 + (lane >> 5) * 4 + (i & 3);
    float rr = sigmoidf_(racc[i] + ba_j);
    float ii = sigmoidf_(iacc[i] + bx_j);
    float log_a = -8.0f * rr * sp_j;
    float a = __expf(log_a);
    float mult = __builtin_amdgcn_sqrtf(fmaxf(1.0f - __expf(2.0f * log_a), 0.f));
    sAa[t * 65 + jch] = a;
    sBb[t * 65 + jch] = mult * ii * sXc[t * 65 + jch];
  }
  __syncthreads();
  float hl[16], pl[16];
  {
    float h = 0.f, p = 1.f;
#pragma unroll
    for (int e = 0; e < 16; ++e) {
      int t = seg * 16 + e;
      float a = sAa[t * 65 + cch], b = sBb[t * 65 + cch];
      h = a * h + b;
      p *= a;
      hl[e] = h;
      pl[e] = p;
    }
    sSegA[seg * 64 + cch] = p;
    sSegH[seg * 64 + cch] = h;
  }
  __syncthreads();
  float cin = sHg[cch], pin = sPg[cch];
  for (int s2 = 0; s2 < seg; ++s2) {
    cin = sSegA[s2 * 64 + cch] * cin + sSegH[s2 * 64 + cch];
    pin *= sSegA[s2 * 64 + cch];
  }
#pragma unroll
  for (int e = 0; e < 16; ++e) {
    const size_t t = (size_t)(t0 + seg * 16 + e);
    hlast = hl[e] + pl[e] * cin;
    plast = pl[e] * pin;
    hloc[t * 1024 + cch] = f2bf(hlast);
    pcum[t * 1024 + cch] = f2bf(plast);
  }
  __syncthreads();
  if (seg == 3) { sHg[cch] = hlast; sPg[cch] = plast; }
  }
  if (seg == 3) {
    float* sumA = (float*)(ws + OFF_SUMA) + ((size_t)b_local * 16 + grp4) * 1024 + c0;
    float* sumH = (float*)(ws + OFF_SUMH) + ((size_t)b_local * 16 + grp4) * 1024 + c0;
    sumA[cch] = plast;
    sumH[cch] = hlast;
  }
}

__device__ void phase_mixers(const Params& P, int g, int cslot, unsigned char* smem) {
  unsigned char* ws = P.ws;
  __shared__ int s_item;
  unsigned* ctr = (unsigned*)(ws + OFF_CTR) + g + cslot;
  constexpr int N_LRU = BPG * 16 * 16;
  constexpr int N_DSWA = BPG * 3 * 4 * 32;
  constexpr int N_MEM = BPG * 4 * 32;
  constexpr int N_ALL = N_LRU + N_DSWA + N_MEM;
  const u16* zq = (const u16*)(ws + OFF_ZQ);
  const u16* zk = (const u16*)(ws + OFF_ZK);
  const u16* zv = (const u16*)(ws + OFF_ZV);
  (void)ctr; (void)s_item;
  for (int it0 = blockIdx.x; it0 < N_ALL; it0 += gridDim.x) {
    int it = it0;
    if (it < N_LRU) {
      lru_chunk_item(P, it >> 8, (it >> 4) & 15, it & 15, smem);
    } else {
      const u16 *Q, *Ka, *Va, *Kb2, *Vb2;
      u16* O;
      float* L;
      size_t qs, kvs, os, lses;
      int mode0, mode1;
      if (it < N_LRU + N_DSWA) {
        int u = it - N_LRU;
        const int blk = u & 31; u >>= 5;
        const int h = u & 3; u >>= 2;
        const int grp = u % 3; const int bl = u / 3;
        const int dl = (grp == 0) ? 1 : (grp == 1 ? 4 : 16);
        const int r = blk % dl, n = blk / dl;
        const size_t tok0 = (size_t)bl * SEQ + (size_t)(n * 128) * dl + r;
        const size_t colo = (size_t)grp * 512 + h * 128;
        const size_t rs = (size_t)dl * 1536;
        Q = zq + tok0 * 1536 + colo;
        Ka = zk + tok0 * 1536 + colo;
        Va = zv + tok0 * 1536 + colo;
        Kb2 = (n > 0) ? Ka - (size_t)128 * rs : Ka;
        Vb2 = (n > 0) ? Va - (size_t)128 * rs : Va;
        O = (u16*)(ws + OFF_OG) + ((size_t)grp * TG + tok0) * 512 + h * 128;
        L = (float*)(ws + OFF_LSE) + ((size_t)grp * TG + tok0) * 4 + h;
        qs = rs; kvs = rs; os = (size_t)dl * 512; lses = (size_t)dl * 4;
        mode0 = 1; mode1 = (n > 0) ? 2 : -1;
      } else {
        int u = it - N_LRU - N_DSWA;
        const int blk = u & 31; u >>= 5;
        const int h = u & 3; const int bl = u >> 2;
        const int b = g * BPG + bl;
        const size_t tok0 = (size_t)bl * SEQ + blk * 128;
        Q = (const u16*)(ws + OFF_ZMQ) + tok0 * 512 + h * 128;
        Ka = (const u16*)(ws + OFF_MEMKV) + (size_t)b * 256 * 1024 + h * 128;
        Va = Ka + 512;
        Kb2 = Ka + (size_t)128 * 1024;
        Vb2 = Va + (size_t)128 * 1024;
        O = (u16*)(ws + OFF_MEMO) + tok0 * 512 + h * 128;
        L = nullptr;
        qs = 512; kvs = 1024; os = 512; lses = 0;
        mode0 = 0; mode1 = 0;
      }
      attn_block(Q, qs, Ka, Va, mode0, Kb2, Vb2, mode1, kvs, O, os, L, lses, (u16*)smem);
    }
  }
}

__device__ void phase_combine(const Params& P) {
  unsigned char* ws = P.ws;
  const u16* og = (const u16*)(ws + OFF_OG);
  const float* lse = (const float*)(ws + OFF_LSE);
  u16* attn = (u16*)(ws + OFF_ATTN);
  const size_t n = (size_t)TG * 64;
  for (size_t idx = (size_t)blockIdx.x * 256 + otid(); idx < n; idx += (size_t)gridDim.x * 256) {
    const size_t row = idx >> 6;
    const int k = (int)(idx & 63) * 8, h = k >> 7;
    float l0 = lse[row * 4 + h], l1 = lse[((size_t)TG + row) * 4 + h], l2 = lse[((size_t)2 * TG + row) * 4 + h];
    float m = fmaxf(l0, fmaxf(l1, l2));
    float e0 = __expf(l0 - m), e1 = __expf(l1 - m), e2 = __expf(l2 - m);
    float inv = 1.0f / (e0 + e1 + e2);
    e0 *= inv; e1 *= inv; e2 *= inv;
    u32x4 a = *(const u32x4*)(og + row * 512 + k);
    u32x4 b = *(const u32x4*)(og + ((size_t)TG + row) * 512 + k);
    u32x4 c = *(const u32x4*)(og + ((size_t)2 * TG + row) * 512 + k);
    u32x4 o;
#pragma unroll
    for (int j = 0; j < 4; ++j)
      o[j] = pack2(e0 * bflo(a[j]) + e1 * bflo(b[j]) + e2 * bflo(c[j]), e0 * bfhi(a[j]) + e1 * bfhi(b[j]) + e2 * bfhi(c[j]));
    *(u32x4*)(attn + row * 512 + k) = o;
  }
  {
    const float* sumA = (const float*)(ws + OFF_SUMA);
    const float* sumH = (const float*)(ws + OFF_SUMH);
    const u16* hloc = (const u16*)(ws + OFF_HLOC);
    const u16* pcum = (const u16*)(ws + OFF_PCUM);
    const u16* zyg = (const u16*)(ws + OFF_ZYG);
    u16* rec = (u16*)(ws + OFF_REC);
    for (int gid = blockIdx.x * 256 + otid(); gid < BPG * 64 * 8 * 128; gid += gridDim.x * 256) {
      const int c8 = (gid & 127) * 8, qt = (gid >> 7) & 7, k = (gid >> 10) & 63, bl = gid >> 16;
      float carry[8];
#pragma unroll
      for (int j = 0; j < 8; ++j) carry[j] = 0.f;
      for (int j = 0; j < (k >> 2); ++j) {
        const size_t o = ((size_t)bl * 16 + j) * 1024 + c8;
        const f32x4 a0 = *(const f32x4*)(sumA + o), a1 = *(const f32x4*)(sumA + o + 4);
        const f32x4 h0 = *(const f32x4*)(sumH + o), h1 = *(const f32x4*)(sumH + o + 4);
#pragma unroll
        for (int e = 0; e < 4; ++e) { carry[e] = a0[e] * carry[e] + h0[e]; carry[4 + e] = a1[e] * carry[4 + e] + h1[e]; }
      }
      const size_t base = ((size_t)bl * SEQ + (size_t)k * 64 + qt * 8) * 1024 + c8;
#pragma unroll 4
      for (int t = 0; t < 8; ++t) {
        const size_t o = base + (size_t)t * 1024;
        const u32x4 hv = *(const u32x4*)(hloc + o), pv = *(const u32x4*)(pcum + o), yv = *(const u32x4*)(zyg + o);
        u32x4 r;
#pragma unroll
        for (int e = 0; e < 4; ++e) {
          const float h0 = bflo(hv[e]) + bflo(pv[e]) * carry[2 * e];
          const float h1 = bfhi(hv[e]) + bfhi(pv[e]) * carry[2 * e + 1];
          r[e] = pack2(h0 * gelu_tanh(bflo(yv[e])), h1 * gelu_tanh(bfhi(yv[e])));
        }
        *(u32x4*)(rec + o) = r;
      }
    }
  }
}

__device__ void phase_merge(const Params& P, int g, unsigned char* smem) {
  unsigned char* ws = P.ws;
  constexpr int NRT = TG / 128, NCT = 8;
  const u16* gates = (const u16*)(ws + ((g & 1) ? OFF_GATES2 : OFF_GATES));
  u16* merged = (u16*)(ws + OFF_MERGED) + (size_t)g * TG * 1024;
  for (int t = blockIdx.x; t < NRT * NCT; t += gridDim.x) {
    const int ct = t / NRT, rt = t % NRT;
    const size_t row0 = (size_t)rt * 128;
    f32x16 acc[2][2];
    f32x4 m2[8][2];
#pragma unroll
    for (int it = 0; it < 8; ++it) { m2[it][0] = (f32x4)(0.f); m2[it][1] = (f32x4)(0.f); }
    const float* sC = (const float*)smem;
#pragma unroll 1
    for (int br = 0; br < 3; ++br) {
      acc_zero(acc);
      {
        const u16* Ap = (br == 0) ? (const u16*)(ws + OFF_ATTN) + row0 * 512
                      : (br == 1) ? (const u16*)(ws + OFF_REC) + row0 * 1024 : (const u16*)(ws + OFF_MEMO) + row0 * 512;
        const unsigned kk = (br == 1) ? 1024u : 512u;
        const u16* Bp = (br == 0) ? (const u16*)(ws + OFF_WBA_T) : (br == 1) ? (const u16*)(ws + OFF_WBL_T) : (const u16*)(ws + OFF_WBM_T);
        LoadBf16 la{Ap, kk, 0};
        gemm_mainloop_t<2, LoadBf16>(acc, la, Bp + (size_t)ct * 128 * kk, kk, (int)kk, (u16*)smem);
      }
      acc_to_lds(acc, (float*)smem);
#pragma unroll
      for (int it = 0; it < 8; ++it) {
        const int idx = otid() + 256 * it, row = idx >> 4, c8 = (idx & 15) * 8;
        f32x4 v0 = *(const f32x4*)(sC + row * 132 + c8), v1 = *(const f32x4*)(sC + row * 132 + c8 + 4);
        u32x4 gt = *(const u32x4*)(gates + (row0 + row) * 3072 + br * 1024 + ct * 128 + c8);
        m2[it][0].x += bflo(gt.x) * v0.x; m2[it][0].y += bfhi(gt.x) * v0.y;
        m2[it][0].z += bflo(gt.y) * v0.z; m2[it][0].w += bfhi(gt.y) * v0.w;
        m2[it][1].x += bflo(gt.z) * v1.x; m2[it][1].y += bfhi(gt.z) * v1.y;
        m2[it][1].z += bflo(gt.w) * v1.z; m2[it][1].w += bfhi(gt.w) * v1.w;
      }
    }
#pragma unroll
    for (int it = 0; it < 8; ++it) {
      const int idx = otid() + 256 * it, row = idx >> 4, c8 = (idx & 15) * 8;
      __builtin_nontemporal_store(pack8(m2[it][0], m2[it][1]), (u32x4*)(merged + (row0 + row) * 1024 + ct * 128 + c8));
    }
  }
}

template <int H2>
__device__ __forceinline__ void outproj_store_half(const Params& P, f32x16 (&acc)[2][4], unsigned char* smem, u16* y,
                                                   size_t row0, int cb0) {
  acc_to_lds_wide<H2>(acc, (float*)smem);
  const float* sC = (const float*)smem;
  const float* x = P.x;
  const int cb = cb0 + H2 * 128;
#pragma unroll 2
  for (int it = 0; it < 8; ++it) {
    const int idx = otid() + 256 * it, row = idx >> 4, c8 = (idx & 15) * 8;
    f32x4 v0 = *(const f32x4*)(sC + row * 132 + c8), v1 = *(const f32x4*)(sC + row * 132 + c8 + 4);
    const size_t o = (row0 + row) * 1024 + cb + c8;
    f32x4 x0 = *(const f32x4*)(x + o), x1 = *(const f32x4*)(x + o + 4);
    __builtin_nontemporal_store(pack8(ALPHA * x0 + v0, ALPHA * x1 + v1), (u32x4*)(y + o));
  }
}
__device__ void phase_outproj(const Params& P, unsigned char* smem) {
  unsigned char* ws = P.ws;
  constexpr int NRT = T_TOK / 128, NCT = 4;
  const u16* merged = (const u16*)(ws + OFF_MERGED);
  u16* y = (u16*)(ws + OFF_Y);
  for (int t = blockIdx.x; t < NRT * NCT; t += gridDim.x) {
    const int ct = t / NRT, rt = t % NRT;
    const size_t row0 = (size_t)rt * 128;
    f32x16 acc[2][4];
#pragma unroll
    for (int mi = 0; mi < 2; ++mi)
#pragma unroll
      for (int ni = 0; ni < 4; ++ni) acc[mi][ni] = zero16();
    LoadBf16 la{merged + row0 * 1024, 1024, 0};
    gemm_mainloop_wide(acc, la, (const u16*)(ws + OFF_WOUT_T) + (size_t)ct * 256 * 1024, 1024, 1024, (u16*)smem);
    outproj_store_half<0>(P, acc, smem, y, row0, ct * 256);
    outproj_store_half<1>(P, acc, smem, y, row0, ct * 256);
  }
}

__device__ void phase_ln1(const Params& P) {
  unsigned char* ws = P.ws;
  const u16* y = (const u16*)(ws + OFF_Y);
  u16* x1b = (u16*)(ws + OFF_XB);
  const int lane = otid() & 63;
  const int gw = blockIdx.x * 4 + (otid() >> 6), nw = gridDim.x * 4;
  for (int row = gw; row < T_TOK; row += nw) {
    const u16* yr = y + (size_t)row * 1024 + lane * 16;
    const u32x4 r0 = *(const u32x4*)yr, r1 = *(const u32x4*)(yr + 8);
    float v[16];
#pragma unroll
    for (int j = 0; j < 4; ++j) {
      v[2 * j] = bflo(r0[j]); v[2 * j + 1] = bfhi(r0[j]);
      v[8 + 2 * j] = bflo(r1[j]); v[8 + 2 * j + 1] = bfhi(r1[j]);
    }
    float s = 0.f;
#pragma unroll
    for (int j = 0; j < 16; ++j) s += v[j];
    const float mu = wave_sum(s) * (1.0f / 1024.0f);
    float q = 0.f;
#pragma unroll
    for (int j = 0; j < 16; ++j) { v[j] -= mu; q += v[j] * v[j]; }
    const float rstd = rsqrtf(wave_sum(q) * (1.0f / 1024.0f) + LN_EPS);
    u32x4 o0, o1;
#pragma unroll
    for (int q4 = 0; q4 < 4; ++q4) {
      const int c = lane * 16 + 4 * q4;
      const f32x4 gg = *(const f32x4*)(P.ln1_g + c), bb = *(const f32x4*)(P.ln1_b + c);
      const unsigned lo = pack2(v[4 * q4] * rstd * gg.x + bb.x, v[4 * q4 + 1] * rstd * gg.y + bb.y);
      const unsigned hi = pack2(v[4 * q4 + 2] * rstd * gg.z + bb.z, v[4 * q4 + 3] * rstd * gg.w + bb.w);
      if (q4 < 2) { o0[2 * q4] = lo; o0[2 * q4 + 1] = hi; } else { o1[2 * (q4 - 2)] = lo; o1[2 * (q4 - 2) + 1] = hi; }
    }
    *(u32x4*)(x1b + (size_t)row * 1024 + lane * 16) = o0;
    *(u32x4*)(x1b + (size_t)row * 1024 + lane * 16 + 8) = o1;
  }
}

template <int H2>
__device__ __forceinline__ void peerq_store_half(f32x16 (&acc)[2][4], unsigned char* smem, u16* pq, size_t row0, int cb0) {
  acc_to_lds_wide<H2>(acc, (float*)smem);
  const float* sC = (const float*)smem;
  const int cb = cb0 + H2 * 128;
#pragma unroll 2
  for (int it = 0; it < 8; ++it) {
    const int idx = otid() + 256 * it, row = idx >> 4, c8 = (idx & 15) * 8;
    f32x4 v0 = *(const f32x4*)(sC + row * 132 + c8), v1 = *(const f32x4*)(sC + row * 132 + c8 + 4);
    __builtin_nontemporal_store(pack8(v0, v1), (u32x4*)(pq + (row0 + row) * 2048 + cb + c8));
  }
}
__device__ void phase_peerq(const Params& P, unsigned char* smem) {
  unsigned char* ws = P.ws;
  constexpr int NRT = T_TOK / 128, NCT = 8;
  const u16* x1b = (const u16*)(ws + OFF_XB);
  u16* pq = (u16*)(ws + OFF_PQ);
  for (int t = blockIdx.x; t < NRT * NCT; t += gridDim.x) {
    const int ct = t / NRT, rt = t % NRT;
    const size_t row0 = (size_t)rt * 128;
    f32x16 acc[2][4];
#pragma unroll
    for (int mi = 0; mi < 2; ++mi)
#pragma unroll
      for (int ni = 0; ni < 4; ++ni) acc[mi][ni] = zero16();
    LoadBf16 la{x1b + row0 * 1024, 1024, 0};
    gemm_mainloop_wide(acc, la, (const u16*)(ws + OFF_WQ_T) + (size_t)ct * 256 * 1024, 1024, 1024, (u16*)smem);
    peerq_store_half<0>(acc, smem, pq, row0, ct * 256);
    peerq_store_half<1>(acc, smem, pq, row0, ct * 256);
  }
}

__device__ void phase_scores(const Params& P, unsigned char* smem) {
  unsigned char* ws = P.ws;
  constexpr int NRT = T_TOK / 128, NHP = 16;
  const u16* pq = (const u16*)(ws + OFF_PQ);
  float* stop = (float*)(ws + OFF_STOP);
  unsigned char* itop = (unsigned char*)(ws + OFF_ITOP);
  float* sS = (float*)smem;
  const int lane = otid() & 63, w = otid() >> 6;
  for (int t = blockIdx.x; t < NRT * NHP; t += gridDim.x) {
    const int hp = t / NRT, rt = t % NRT;
    const size_t row0 = (size_t)rt * 128;
    f32x16 acc[2][2];
    acc_zero(acc);
    LoadBf16 la{pq + row0 * 2048 + hp * 128, 2048, 0};
    gemm_mainloop(acc, la, (const u16*)(ws + OFF_KEYS) + (size_t)hp * 128 * 128, 128, 128, (u16*)smem);
    acc_to_lds(acc, sS);
    {
      const int row = w * 32 + (lane & 31), hh = lane >> 5;
      const float* src = sS + row * 132 + hh * 64;
#define CE_DESC(x_, y_) { const unsigned hi_ = max(x_, y_), lo_ = min(x_, y_); x_ = hi_; y_ = lo_; }
#define BSTAGE(ARR, KK, JJ)                                                          \
      _Pragma("unroll") for (int i = 0; i < 16; ++i) {                                \
        if ((i ^ (JJ)) > i) {                                                         \
          if ((i & (KK)) == 0) CE_DESC(ARR[i], ARR[i ^ (JJ)])                         \
          else CE_DESC(ARR[i ^ (JJ)], ARR[i])                                         \
        }                                                                             \
      }
#define MERGE16(ARR) BSTAGE(ARR, 16, 8) BSTAGE(ARR, 16, 4) BSTAGE(ARR, 16, 2) BSTAGE(ARR, 16, 1)
#define SORT16(ARR) BSTAGE(ARR, 2, 1) BSTAGE(ARR, 4, 2) BSTAGE(ARR, 4, 1) BSTAGE(ARR, 8, 4) BSTAGE(ARR, 8, 2) BSTAGE(ARR, 8, 1) MERGE16(ARR)
      unsigned L[16], LB[16], LC[16], LD[16];
#pragma unroll
      for (int q = 0; q < 4; ++q) {
        const f32x4 va = *(const f32x4*)(src + 4 * q), vb = *(const f32x4*)(src + 16 + 4 * q);
        const f32x4 vc = *(const f32x4*)(src + 32 + 4 * q), vd = *(const f32x4*)(src + 48 + 4 * q);
#pragma unroll
        for (int e = 0; e < 4; ++e) {
          const int p = 4 * q + e;
          L[p] = (f2ord(va[e]) & 0xFFFFFF80u) | (unsigned)(127 - (hh * 64 + p));
          LB[p] = (f2ord(vb[e]) & 0xFFFFFF80u) | (unsigned)(127 - (hh * 64 + 16 + p));
          LC[p] = (f2ord(vc[e]) & 0xFFFFFF80u) | (unsigned)(127 - (hh * 64 + 32 + p));
          LD[p] = (f2ord(vd[e]) & 0xFFFFFF80u) | (unsigned)(127 - (hh * 64 + 48 + p));
        }
      }
      SORT16(L) SORT16(LB) SORT16(LC) SORT16(LD)
#pragma unroll
      for (int i = 0; i < 16; ++i) { L[i] = max(L[i], LB[15 - i]); LC[i] = max(LC[i], LD[15 - i]); }
      MERGE16(L) MERGE16(LC)
#pragma unroll
      for (int i = 0; i < 16; ++i) L[i] = max(L[i], LC[15 - i]);
      MERGE16(L)
      unsigned M[16];
#pragma unroll
      for (int i = 0; i < 16; ++i) {
        const unsigned pv = (unsigned)__shfl_xor((int)L[15 - i], 32, 64);
        M[i] = max(L[i], pv);
      }
      MERGE16(M)
#undef SORT16
#undef MERGE16
#undef BSTAGE
#undef CE_DESC
      float sc[8];
      unsigned ib[2] = {0u, 0u};
#pragma unroll
      for (int i = 0; i < 8; ++i) {
        const unsigned hmask = 0u - (unsigned)hh;
        const unsigned mk = (M[8 + i] & hmask) | (M[i] & ~hmask);
        const int idx = 127 - (int)(mk & 127u);
        sc[i] = sS[row * 132 + idx];
        ib[i >> 2] |= (unsigned)idx << (8 * (i & 3));
      }
      const size_t o = ((row0 + row) * 16 + hp) * 16 + hh * 8;
      f32x4 o0 = {sc[0], sc[1], sc[2], sc[3]}, o1 = {sc[4], sc[5], sc[6], sc[7]};
      *(f32x4*)(stop + o) = o0;
      *(f32x4*)(stop + o + 4) = o1;
      u32x2 ob = {ib[0], ib[1]};
      *(u32x2*)(itop + o) = ob;
    }
  }
}

__device__ __forceinline__ void peer_load8(const u32x4* myE, int e0, int lane, const unsigned char* ub, const unsigned char* vb,
                                           u32x4& rec, u32x4 (&uq)[8], u32x2 (&vq)[8]) {
  rec = myE[e0 + (lane & 7)];
#pragma unroll
  for (int q = 0; q < 8; ++q) {
    const int id = __builtin_amdgcn_readlane((int)rec.x, q);
    uq[q] = *(const u32x4*)(ub + (size_t)id * 1024 + lane * 16);
    vq[q] = *(const u32x2*)(vb + (size_t)id * 512 + lane * 8);
  }
}
__device__ __forceinline__ void peer_eval8(int lane, const u32x4& rec, const u32x4 (&uq)[8], const u32x2 (&vq)[8],
                                           const f32x2 (&xv2)[8], f32x2 (&facc2)[8]) {
  float dl = 0.f;
#pragma unroll
  for (int q = 0; q < 8; ++q) {
    f32x2 d2 = f32x2{0.f, 0.f};
#pragma unroll
    for (int j = 0; j < 4; ++j) {
      const f32x2 lo = __builtin_amdgcn_cvt_pk_f32_fp8((int)uq[q][j], false);
      const f32x2 hi = __builtin_amdgcn_cvt_pk_f32_fp8((int)uq[q][j], true);
      d2 += lo * xv2[2 * j];
      d2 += hi * xv2[2 * j + 1];
    }
    const float d = wave_sum(d2.x + d2.y);
    dl = ((lane & 7) == q) ? d : dl;
  }
  const float cfl = __uint_as_float(rec.y) * gelu_erf(dl * __uint_as_float(rec.z));
#pragma unroll
  for (int q = 0; q < 8; ++q) {
    const float cf = __builtin_bit_cast(float, __builtin_amdgcn_readlane(__builtin_bit_cast(int, cfl), q));
    const f32x2 cf2 = f32x2{cf, cf};
#pragma unroll
    for (int wd = 0; wd < 2; ++wd) {
      facc2[4 * wd + 0] += cf2 * __builtin_amdgcn_cvt_scalef32_pk_f32_fp4(vq[q][wd], 1.0f, 0);
      facc2[4 * wd + 1] += cf2 * __builtin_amdgcn_cvt_scalef32_pk_f32_fp4(vq[q][wd], 1.0f, 1);
      facc2[4 * wd + 2] += cf2 * __builtin_amdgcn_cvt_scalef32_pk_f32_fp4(vq[q][wd], 1.0f, 2);
      facc2[4 * wd + 3] += cf2 * __builtin_amdgcn_cvt_scalef32_pk_f32_fp4(vq[q][wd], 1.0f, 3);
    }
  }
}

__device__ void phase_experts(const Params& P, unsigned char* smem) {
  unsigned char* ws = P.ws;
  const u16* x1 = (const u16*)(ws + OFF_XB);
  const float* stop = (const float*)(ws + OFF_STOP);
  const unsigned char* itop = (const unsigned char*)(ws + OFF_ITOP);
  const unsigned char* ub = ws + OFF_UB;
  const unsigned char* vb = ws + OFF_VB;
  const float* uscale = (const float*)(ws + OFF_UB + (size_t)16384 * 1024);
  const float* vscale = (const float*)(ws + OFF_VB + (size_t)16384 * 1024);
  const int tid = otid(), lane = tid & 63, w = tid >> 6;
  u32x4* sE = (u32x4*)smem;
  for (int tb = blockIdx.x; tb < T_TOK / 32; tb += gridDim.x) {
    __syncthreads();
    {
      const int tl = tid >> 3, h = tid & 7;
      const size_t tok = (size_t)tb * 32 + tl;
      const size_t ba = (tok * 16 + h * 2) * 16, bb = ba + 16;
      float sa[16], sb[16];
#pragma unroll
      for (int q = 0; q < 4; ++q) {
        f32x4 va = *(const f32x4*)(stop + ba + 4 * q), vb4 = *(const f32x4*)(stop + bb + 4 * q);
#pragma unroll
        for (int e = 0; e < 4; ++e) { sa[4 * q + e] = va[e]; sb[4 * q + e] = vb4[e]; }
      }
      unsigned L[16];
#pragma unroll
      for (int j = 0; j < 16; ++j) L[j] = 0u;
#pragma unroll
      for (int k1 = 0; k1 < 16; ++k1) {
#pragma unroll
        for (int k2 = 0; k2 < 16; ++k2) {
          if ((k1 + 1) * (k2 + 1) <= 16) {
            const unsigned key = (f2ord(sa[k1] + sb[k2]) & 0xFFFFFF00u) | (unsigned)(255 - (k1 * 16 + k2));
            TOPK_INSERT(L, key);
          }
        }
      }
      const float m0 = ord2f(L[0] & 0xFFFFFF00u);
      float ev[16], ssum = 0.f;
#pragma unroll
      for (int i = 0; i < 16; ++i) { ev[i] = __expf(ord2f(L[i] & 0xFFFFFF00u) - m0); ssum += ev[i]; }
      const float inv = 1.0f / ssum;
#pragma unroll
      for (int i = 0; i < 16; ++i) {
        const int flat = 255 - (int)(L[i] & 255u);
        const int ia = itop[ba + (flat >> 4)], ib = itop[bb + (flat & 15)];
        const int id = ia * 128 + ib;
        u32x4 rec = {(unsigned)id, __float_as_uint(ev[i] * inv * vscale[id]), __float_as_uint(uscale[id]), 0u};
        sE[tl * 128 + h * 16 + i] = rec;
      }
    }
    __syncthreads();
    for (int tt = 0; tt < 8; ++tt) {
      const int tl = w * 8 + tt;
      const size_t tok = (size_t)tb * 32 + tl;
      f32x2 xv2[8];
      {
        const u16* xr = x1 + tok * 1024 + lane * 16;
        const u32x4 r0 = *(const u32x4*)xr, r1 = *(const u32x4*)(xr + 8);
#pragma unroll
        for (int j = 0; j < 4; ++j) {
          xv2[j] = f32x2{bflo(r0[j]), bfhi(r0[j])};
          xv2[4 + j] = f32x2{bflo(r1[j]), bfhi(r1[j])};
        }
      }
      f32x2 facc2[8];
#pragma unroll
      for (int j = 0; j < 8; ++j) facc2[j] = f32x2{0.f, 0.f};
      const u32x4* myE = sE + tl * 128;
      {
        u32x4 recA, recB, uqA[8], uqB[8];
        u32x2 vqA[8], vqB[8];
        peer_load8(myE, 0, lane, ub, vb, recA, uqA, vqA);
#pragma unroll 1
        for (int e0 = 0; e0 < 128; e0 += 16) {
          peer_load8(myE, e0 + 8, lane, ub, vb, recB, uqB, vqB);
          peer_eval8(lane, recA, uqA, vqA, xv2, facc2);
          if (e0 + 16 < 128) peer_load8(myE, e0 + 16, lane, ub, vb, recA, uqA, vqA);
          peer_eval8(lane, recB, uqB, vqB, xv2, facc2);
        }
      }
      float xv[16], facc[16];
#pragma unroll
      for (int j = 0; j < 8; ++j) { xv[2 * j] = xv2[j].x; xv[2 * j + 1] = xv2[j].y; facc[2 * j] = facc2[j].x; facc[2 * j + 1] = facc2[j].y; }
      float sm = 0.f;
#pragma unroll
      for (int j = 0; j < 16; ++j) { xv[j] = ALPHA * xv[j] + facc[j]; sm += xv[j]; }
      const float mu = wave_sum(sm) * (1.0f / 1024.0f);
      float q2 = 0.f;
#pragma unroll
      for (int j = 0; j < 16; ++j) { xv[j] -= mu; q2 += xv[j] * xv[j]; }
      const float rstd = rsqrtf(wave_sum(q2) * (1.0f / 1024.0f) + LN_EPS);
      float* orow = P.out + tok * 1024 + lane * 16;
#pragma unroll
      for (int q = 0; q < 4; ++q) {
        const int c = lane * 16 + 4 * q;
        f32x4 gg = *(const f32x4*)(P.ln2_g + c), bb2 = *(const f32x4*)(P.ln2_b + c);
        f32x4 o;
#pragma unroll
        for (int j = 0; j < 4; ++j) o[j] = xv[4 * q + j] * rstd * gg[j] + bb2[j];
        *(f32x4*)(orow + 4 * q) = o;
      }
    }
  }
}

#define XB_TMO      128
#define XB_XCNT(j)  (256  + 64 * (j))
#define XB_XSUB(j)  (1280 + 64 * (j))
#define XB_XGEN(j)  (2304 + 64 * (j))
#define XB_TOP      3328
#define XB_TOPGEN   3392
#define XB_SPIN_CAP (1u << 22)
__device__ __forceinline__ unsigned xb_ld(unsigned* p) { return __hip_atomic_load(p, __ATOMIC_RELAXED, __HIP_MEMORY_SCOPE_AGENT); }
__device__ __forceinline__ unsigned xb_add(unsigned* p, unsigned v) { return __hip_atomic_fetch_add(p, v, __ATOMIC_RELAXED, __HIP_MEMORY_SCOPE_AGENT); }
__device__ __forceinline__ unsigned xb_xcc_id() { return (unsigned)__builtin_amdgcn_s_getreg((3 << 11) | 20) & 0xFu; }
#define XB_SPIN(cond, bar) do { unsigned _sp = 0; while (cond) { __builtin_amdgcn_s_sleep(1); \
    if ((++_sp & 255u) == 0u) { if (xb_ld(&(bar)[XB_TMO])) break; if (_sp > XB_SPIN_CAP) { atomicAdd(&(bar)[XB_TMO], 1u); break; } } } } while (0)

__device__ __forceinline__ void grid_barrier(unsigned* bar, unsigned xcc, volatile unsigned* st) {
  asm volatile("s_waitcnt vmcnt(0)" ::: "memory");
  __syncthreads();
  if (threadIdx.x == 0) {
    __builtin_amdgcn_s_waitcnt(0);
    unsigned nloc = st[0], nx = st[1];
    if (nloc == 0u) {
      const unsigned G = gridDim.x;
      unsigned sum, cnt, mine, sp = 0u;
      for (;;) {
        sum = 0u; cnt = 0u; mine = 0u;
#pragma unroll
        for (unsigned j = 0; j < 16; ++j) { const unsigned c = xb_ld(&bar[XB_XCNT(j)]); sum += c; cnt += (c > 0u) ? 1u : 0u; mine = (j == xcc) ? c : mine; }
        if (sum == G) break;
        __builtin_amdgcn_s_sleep(1);
        if ((++sp & 255u) == 0u) { if (xb_ld(&bar[XB_TMO])) break; if (sp > XB_SPIN_CAP) { atomicAdd(&bar[XB_TMO], 1u); break; } }
      }
      nloc = mine > 0u ? mine : 1u; nx = cnt > 0u ? cnt : 1u;
      st[0] = nloc; st[1] = nx;
    }
    const unsigned old = xb_add(&bar[XB_XSUB(xcc)], 1u);
    const unsigned gen = old / nloc;
    if (old + 1u == (gen + 1u) * nloc) {
      __builtin_amdgcn_fence(__ATOMIC_RELEASE, "agent");
      asm volatile("s_waitcnt vmcnt(0)" ::: "memory");
      const unsigned og = xb_add(&bar[XB_TOP], 1u);
      const unsigned tg = og / nx;
      if (og + 1u == (tg + 1u) * nx) xb_add(&bar[XB_TOPGEN], 1u);
      else XB_SPIN(xb_ld(&bar[XB_TOPGEN]) == tg, bar);
      __builtin_amdgcn_fence(__ATOMIC_ACQUIRE, "agent");
      xb_add(&bar[XB_XGEN(xcc)], 1u);
      asm volatile("s_waitcnt vmcnt(0)" ::: "memory");
    } else {
      XB_SPIN(xb_ld(&bar[XB_XGEN(xcc)]) == gen, bar);
      __builtin_amdgcn_fence(__ATOMIC_ACQUIRE, "agent");
      asm volatile("s_waitcnt vmcnt(0)" ::: "memory");
    }
  }
  __syncthreads();
}

__global__ void __launch_bounds__(256, 2) hybrid_fwd(Params P) {
  cg::grid_group grid = cg::this_grid();
  __shared__ __attribute__((aligned(16))) unsigned char smem[SMEM_BYTES];
#ifndef PHM
#define PHM 0x1ff
#endif
#ifndef DUP
#define DUP 0
#endif
  unsigned* bar = (unsigned*)(P.ws + OFF_CTR) + 1024;
  __shared__ __attribute__((aligned(16))) unsigned xb_words[4];
  if (threadIdx.x == 0) { xb_words[0] = 0u; xb_words[1] = 0u; }
  const unsigned xcc = xb_xcc_id();
  if (threadIdx.x == 0) (void)xb_add(&bar[XB_XCNT(xcc)], 1u);
  __syncthreads();
#define REPS(bit) (1 + ((DUP & (bit)) ? 1 : 0))
  phase_prep(P, smem, 0);
  if (P.out == nullptr) grid.sync();
  grid_barrier(bar, xcc, xb_words);
  for (int step = 0; step <= NGRP; ++step) {
    const bool merge_first = ((blockIdx.x >> 3) & 1) != 0;
#pragma unroll 1
    for (int part = 0; part < 2; ++part) {
      const bool do_merge = (part == 0) == merge_first;
      if (do_merge) { if (step >= 1) phase_merge(P, step - 1, smem); else phase_prep(P, smem, 1); }
      else { if (step < NGRP) phase_inproj(P, step, smem); }
    }
    grid_barrier(bar, xcc, xb_words);
    if (step < NGRP) {
      phase_mixers(P, step, 0, smem);
      grid_barrier(bar, xcc, xb_words);
      phase_combine(P);
      grid_barrier(bar, xcc, xb_words);
    }
  }
  for (int rep = 0; rep < REPS(16); ++rep) { phase_outproj(P, smem); if (rep + 1 < REPS(16)) grid_barrier(bar, xcc, xb_words); }
  grid_barrier(bar, xcc, xb_words);
  phase_ln1(P);
  grid_barrier(bar, xcc, xb_words);
  {
    const bool quant_first = ((blockIdx.x >> 3) & 1) != 0;
#pragma unroll 1
    for (int part = 0; part < 2; ++part) {
      if ((part == 0) == quant_first) {
        quantize_rows_fp8(P.peer_u, P.ws + OFF_UB, (float*)(P.ws + OFF_UB + (size_t)16384 * 1024));
        quantize_rows_fp4(P.peer_v, P.ws + OFF_VB, (float*)(P.ws + OFF_VB + (size_t)16384 * 1024));
      } else {
        phase_peerq(P, smem);
      }
    }
  }
  grid_barrier(bar, xcc, xb_words);
  for (int rep = 0; rep < REPS(128); ++rep) { phase_scores(P, smem); if (rep + 1 < REPS(128)) grid_barrier(bar, xcc, xb_words); }
  grid_barrier(bar, xcc, xb_words);
  for (int rep = 0; rep < REPS(256); ++rep) { phase_experts(P, smem); if (rep + 1 < REPS(256)) grid_barrier(bar, xcc, xb_words); }
}

extern "C" void kernel_launch(void* const* d_in, const int* in_sizes, int n_in, void* d_out, int out_size, void* d_ws,
                              size_t ws_size, hipStream_t stream) {
  static int grid_blocks = 0;
  if (grid_blocks == 0) {
    if (n_in != 24 || ws_size < WS_END) {
      fprintf(stderr, "kernel_launch: unexpected n_in %d or ws_size %zu (< %zu)\n", n_in, ws_size, (size_t)WS_END);
      grid_blocks = -1;
      return;
    }
    int dev = 0, cus = 0, per_cu = 0;
    (void)hipGetDevice(&dev);
    (void)hipDeviceGetAttribute(&cus, hipDeviceAttributeMultiprocessorCount, dev);
    (void)hipOccupancyMaxActiveBlocksPerMultiprocessor(&per_cu, (const void*)hybrid_fwd, 256, 0);
    if (per_cu < 1) { fprintf(stderr, "kernel_launch: occupancy query returned %d\n", per_cu); grid_blocks = -1; return; }
    if (per_cu > 2) per_cu = 2;
    grid_blocks = cus * per_cu;
  }
  if (grid_blocks < 0) return;
  (void)hipMemsetAsync((unsigned char*)d_ws + OFF_CTR, 0, 32768, stream);
  Params p{};
  const float** pp = (const float**)&p;
  for (int i = 0; i < 24; ++i) pp[i] = (const float*)d_in[i];
  p.out = (float*)d_out;
  p.ws = (unsigned char*)d_ws;
  void* args[] = {&p};
  hipError_t e = hipLaunchCooperativeKernel((const void*)hybrid_fwd, dim3(grid_blocks), dim3(256), args, 0, stream);
  if (e != hipSuccess) fprintf(stderr, "cooperative launch failed: %s (grid %d)\n", hipGetErrorString(e), grid_blocks);
}
```
